# Optimizing an MI355X kernel written in HIP

```python
import math
import jax
import jax.numpy as jnp
from jax import lax
import numpy as np

D_MODEL = 1024
BATCH = 8
SEQ = 4096
DEPTH = 2

GRID_W = 64
CTX_LEN = 256

N_HEADS_ATTN = 4
HEAD_DIM_QK = 64
HEAD_DIM_V = 2 * HEAD_DIM_QK
QK_W = N_HEADS_ATTN * 2 * HEAD_DIM_QK
ATTN_W = N_HEADS_ATTN * HEAD_DIM_V
ROPE_BASE = 10000.0
ROPE_FREQS = HEAD_DIM_QK // 4
Q_BLOCK = 128

CONV_W = 512
CONV_K = 3

POOL_WINDOWS = (2, 4, 8, 16)
POOL_GROUPS = 4
POOL_W = 512
POOL_GW = POOL_W // POOL_GROUPS

N_BRANCH = 3
Q_END = QK_W
K_END = Q_END + QK_W
V_END = K_END + ATTN_W
CB_END = V_END + CONV_W
CC_END = CB_END + CONV_W
CX_END = CC_END + CONV_W
P_END = CX_END + POOL_W
IN_W = P_END + N_BRANCH * D_MODEL

D_FF = 2816
N_EXPERTS = 8
TOP_K = 2
N_DENSE = (DEPTH + 1) // 2
N_MOE = DEPTH // 2

EPS = 1e-6

kernel_name = "hybrid_diffattn_conv_pool_moe_dit"


def rmsnorm(t, g):
    tf = t.astype(jnp.float32)
    n = tf * lax.rsqrt(jnp.mean(tf * tf, axis=-1, keepdims=True) + EPS)
    return (n * g.astype(jnp.float32)).astype(t.dtype)


def modulate(t, shift, scale):
    return t * (1 + scale) + shift


def rope_tables(rows, cols):
    inv = ROPE_BASE ** (-jnp.arange(ROPE_FREQS, dtype=jnp.float32) / ROPE_FREQS)
    ang = jnp.stack([rows.astype(jnp.float32)[:, None] * inv,
                     cols.astype(jnp.float32)[:, None] * inv], axis=1)
    ang = jnp.broadcast_to(ang[:, :, None, :], (ang.shape[0], 2, 2, ROPE_FREQS))
    ang = ang.reshape(ang.shape[0], HEAD_DIM_QK)
    return jnp.cos(ang), jnp.sin(ang)


def apply_rope(t, cos, sin):
    tr = t.reshape(t.shape[:-1] + (2, 2, ROPE_FREQS))
    rot = jnp.concatenate([-tr[..., 1:2, :], tr[..., 0:1, :]], axis=-2).reshape(t.shape)
    c = cos[None, :, None, None, :]
    s = sin[None, :, None, None, :]
    return (t * c + rot * s).astype(t.dtype)


def heads_qk(t):
    return t.reshape(t.shape[:-1] + (N_HEADS_ATTN, 2, HEAD_DIM_QK))


def heads_v(t):
    return t.reshape(t.shape[:-1] + (N_HEADS_ATTN, HEAD_DIM_V))


def diff_attention(q, k, v, lam):
    B, L = q.shape[0], q.shape[1]
    nblk = L // Q_BLOCK
    qb = jnp.moveaxis(q.reshape((B, nblk, Q_BLOCK) + q.shape[2:]), 1, 0)
    scale = HEAD_DIM_QK ** -0.5

    def block(qi):
        s = jnp.einsum('bqhmd,bkhmd->bhmqk', qi, k).astype(jnp.float32) * scale
        p = jax.nn.softmax(s, axis=-1)
        a = p[:, :, 0] - lam * p[:, :, 1]
        return jnp.einsum('bhqk,bkhe->bqhe', a.astype(v.dtype), v)

    o = lax.map(block, qb)
    return jnp.moveaxis(o, 0, 1).reshape(B, L, N_HEADS_ATTN, HEAD_DIM_V)


def short_conv(u, w):
    p = jnp.pad(u, ((0, 0), (1, 1), (0, 0)))
    return w[0] * p[:, :-2] + w[1] * p[:, 1:-1] + w[2] * p[:, 2:]


def multiscale_pool(u, pool_w, pool_scale):
    B, L = u.shape[0], u.shape[1]
    ug = u.reshape(B, L, POOL_GROUPS, POOL_GW)
    cs = jnp.pad(jnp.cumsum(ug.astype(jnp.float32), axis=1), ((0, 0), (1, 0), (0, 0), (0, 0)))
    t = jnp.arange(L)
    outs = []
    for g, w in enumerate(POOL_WINDOWS):
        lo = jnp.clip(t - w // 2, 0, L)
        hi = jnp.clip(t - w // 2 + w, 0, L)
        csg = cs[:, :, g]
        mean = (csg[:, hi] - csg[:, lo]) / (hi - lo).astype(jnp.float32)[None, :, None]
        outs.append(mean - ug[:, :, g].astype(jnp.float32))
    p = jnp.stack(outs, axis=2).astype(u.dtype)
    y = jnp.einsum('blgc,gcd->blgd', p, pool_w).reshape(B, L, POOL_W)
    return y * pool_scale


def mixer_merge(attn_heads, cb, cc, cx, pin, gts, g_sub, lam_init, conv_w_i, pool_w_i,
                pool_scale_i, w_branch_i, w_out_i):
    B, L = cb.shape[0], cb.shape[1]
    attn_o = (rmsnorm(attn_heads, g_sub) * (1.0 - lam_init)).reshape(B, L, ATTN_W)
    conv_o = cb * short_conv(cc * cx, conv_w_i)
    pool_o = multiscale_pool(pin, pool_w_i, pool_scale_i)
    g = jax.nn.sigmoid(gts.reshape(B, L, N_BRANCH, D_MODEL))
    merged = (g[:, :, 0] * (attn_o @ w_branch_i[0])
              + g[:, :, 1] * (conv_o @ w_branch_i[1])
              + g[:, :, 2] * (pool_o @ w_branch_i[2]))
    return merged @ w_out_i


def swiglu(h, wg, wu, wd):
    return (jax.nn.silu(h @ wg) * (h @ wu)) @ wd


def moe_ffn(h, wr, wg, wu, wd):
    logits = (h @ wr).astype(jnp.float32)
    top_v, top_i = lax.top_k(logits, TOP_K)
    top_p = jax.nn.softmax(top_v, axis=-1)
    combine = jnp.sum(jax.nn.one_hot(top_i, N_EXPERTS, dtype=jnp.float32) * top_p[..., None],
                      axis=-2).astype(h.dtype)
    out = jnp.zeros_like(h)
    for e in range(N_EXPERTS):
        out = out + combine[..., e:e + 1] * swiglu(h, wg[e], wu[e], wd[e])
    return out


def setup_inputs(seed: int = 0) -> dict:
    key = jax.random.key(seed)
    ks = jax.random.split(key, 32)
    f32 = jnp.float32
    D = D_MODEL

    def nrm(k, shape, scale):
        return jax.random.normal(k, shape, f32) * scale

    return {
        "x": nrm(ks[0], (BATCH, SEQ, D), 1.0),
        "c": nrm(ks[1], (BATCH, D), 1.0),
        "ctx": nrm(ks[2], (BATCH, CTX_LEN, D), 1.0),
        "c_ctx": nrm(ks[3], (D,), 1.0),
        "w_mod": nrm(ks[4], (DEPTH, D, 6 * D), 0.5 * D ** -0.5),
        "b_mod": nrm(ks[5], (DEPTH, 6 * D), 0.01),
        "g_pre_mix": 1.0 + nrm(ks[6], (DEPTH, D), 0.05),
        "g_post_mix": 1.0 + nrm(ks[7], (DEPTH, D), 0.05),
        "g_pre_ffn": 1.0 + nrm(ks[8], (DEPTH, D), 0.05),
        "g_post_ffn": 1.0 + nrm(ks[9], (DEPTH, D), 0.05),
        "w_in": nrm(ks[10], (DEPTH, D, IN_W), D ** -0.5),
        "lambda_q1": nrm(ks[11], (DEPTH, HEAD_DIM_QK), 0.1),
        "lambda_k1": nrm(ks[12], (DEPTH, HEAD_DIM_QK), 0.1),
        "lambda_q2": nrm(ks[13], (DEPTH, HEAD_DIM_QK), 0.1),
        "lambda_k2": nrm(ks[14], (DEPTH, HEAD_DIM_QK), 0.1),
        "g_subln": 1.0 + nrm(ks[15], (DEPTH, HEAD_DIM_V), 0.05),
        "conv_w": nrm(ks[16], (DEPTH, CONV_K, CONV_W), CONV_K ** -0.5),
        "pool_w": nrm(ks[17], (DEPTH, POOL_GROUPS, POOL_GW, POOL_GW), POOL_GW ** -0.5),
        "pool_scale": 1.0 + nrm(ks[18], (DEPTH, POOL_W), 0.05),
        "w_branch": nrm(ks[19], (DEPTH, N_BRANCH, ATTN_W, D), ATTN_W ** -0.5),
        "w_out": nrm(ks[20], (DEPTH, D, D), D ** -0.5),
        "ffn_w_gate": nrm(ks[21], (N_DENSE, D, D_FF), D ** -0.5),
        "ffn_w_up": nrm(ks[22], (N_DENSE, D, D_FF), D ** -0.5),
        "ffn_w_down": nrm(ks[23], (N_DENSE, D_FF, D), D_FF ** -0.5),
        "router_w": nrm(ks[24], (N_MOE, D, N_EXPERTS), D ** -0.5),
        "moe_w_gate": nrm(ks[25], (N_MOE, N_EXPERTS, D, D_FF), D ** -0.5),
        "moe_w_up": nrm(ks[26], (N_MOE, N_EXPERTS, D, D_FF), D ** -0.5),
        "moe_w_down": nrm(ks[27], (N_MOE, N_EXPERTS, D_FF, D), D_FF ** -0.5),
    }


def reference(x, c, ctx, c_ctx, w_mod, b_mod, g_pre_mix, g_post_mix, g_pre_ffn, g_post_ffn,
              w_in, lambda_q1, lambda_k1, lambda_q2, lambda_k2, g_subln, conv_w, pool_w,
              pool_scale, w_branch, w_out, ffn_w_gate, ffn_w_up, ffn_w_down, router_w,
              moe_w_gate, moe_w_up, moe_w_down):
    S = x.shape[1]
    ROWS = S // GRID_W
    rows = jnp.repeat(jnp.arange(ROWS), GRID_W)
    cols = jnp.tile(jnp.arange(GRID_W), ROWS)
    cos, sin = rope_tables(rows, cols)
    y = ctx

    for i in range(DEPTH):
        last = i == DEPTH - 1
        mod_lat = (jax.nn.silu(c) @ w_mod[i] + b_mod[i])[:, None, :]
        mod_ctx = jax.nn.silu(c_ctx) @ w_mod[i] + b_mod[i]
        sh_m, sc_m, gt_m, sh_f, sc_f, gt_f = jnp.split(mod_lat, 6, axis=-1)
        csh_m, csc_m, cgt_m, csh_f, csc_f, cgt_f = jnp.split(mod_ctx, 6, axis=-1)

        lam_init = 0.8 - 0.6 * math.exp(-0.3 * i)
        lam = (jnp.exp(jnp.sum(lambda_q1[i].astype(jnp.float32) * lambda_k1[i].astype(jnp.float32)))
               - jnp.exp(jnp.sum(lambda_q2[i].astype(jnp.float32) * lambda_k2[i].astype(jnp.float32)))
               + lam_init)

        h_lat = modulate(rmsnorm(x, g_pre_mix[i]), sh_m, sc_m)
        h_ctx = modulate(rmsnorm(y, g_pre_mix[i]), csh_m, csc_m)

        z = h_lat @ w_in[i]
        q, k, v, cb, cc, cx, pin, gts = jnp.split(
            z, [Q_END, K_END, V_END, CB_END, CC_END, CX_END, P_END], axis=-1)
        q = apply_rope(heads_qk(q), cos, sin)
        k = apply_rope(heads_qk(k), cos, sin)
        v = heads_v(v)

        if last:
            kc, vc = jnp.split(h_ctx @ w_in[i][:, Q_END:V_END], [QK_W], axis=-1)
            kc, vc = heads_qk(kc), heads_v(vc)
        else:
            zc = h_ctx @ w_in[i]
            qc, kc, vc, cbc, ccc, cxc, pinc, gtsc = jnp.split(
                zc, [Q_END, K_END, V_END, CB_END, CC_END, CX_END, P_END], axis=-1)
            qc, kc, vc = heads_qk(qc), heads_qk(kc), heads_v(vc)
            attn_c = diff_attention(qc, kc, vc, lam)
            mix_c = mixer_merge(attn_c, cbc, ccc, cxc, pinc, gtsc, g_subln[i], lam_init, conv_w[i],
                                pool_w[i], pool_scale[i], w_branch[i], w_out[i])

        k_all = jnp.concatenate([kc, k], axis=1)
        v_all = jnp.concatenate([vc, v], axis=1)
        attn_l = diff_attention(q, k_all, v_all, lam)
        mix_l = mixer_merge(attn_l, cb, cc, cx, pin, gts, g_subln[i], lam_init, conv_w[i],
                            pool_w[i], pool_scale[i], w_branch[i], w_out[i])
        x = x + gt_m * rmsnorm(mix_l, g_post_mix[i])
        if not last:
            y = y + cgt_m * rmsnorm(mix_c, g_post_mix[i])

        j = i // 2
        h2 = modulate(rmsnorm(x, g_pre_ffn[i]), sh_f, sc_f)
        if i % 2 == 0:
            f = swiglu(h2, ffn_w_gate[j], ffn_w_up[j], ffn_w_down[j])
        else:
            f = moe_ffn(h2, router_w[j], moe_w_gate[j], moe_w_up[j], moe_w_down[j])
        x = x + gt_f * rmsnorm(f, g_post_ffn[i])
        if not last:
            h2c = modulate(rmsnorm(y, g_pre_ffn[i]), csh_f, csc_f)
            if i % 2 == 0:
                fc = swiglu(h2c, ffn_w_gate[j], ffn_w_up[j], ffn_w_down[j])
            else:
                fc = moe_ffn(h2c, router_w[j], moe_w_gate[j], moe_w_up[j], moe_w_down[j])
            y = y + cgt_f * rmsnorm(fc, g_post_ffn[i])

    return x
```

```cpp
#include <hip/hip_runtime.h>
#include <cstdio>
#include <cstdint>

#ifndef MK_MULTI
#define MK_MULTI 1
#endif

#define LAS __attribute__((address_space(3)))
#define GAS __attribute__((address_space(1)))
typedef unsigned short bf16_t;
typedef short bf16x8 __attribute__((ext_vector_type(8)));
typedef short s16x4 __attribute__((ext_vector_type(4)));
typedef float f32x2 __attribute__((ext_vector_type(2)));
typedef float f32x4 __attribute__((ext_vector_type(4)));
typedef float f32x16 __attribute__((ext_vector_type(16)));
typedef unsigned u32x2 __attribute__((ext_vector_type(2)));
typedef unsigned u32x4 __attribute__((ext_vector_type(4)));

constexpr int NB = 8, SEQ = 4096, DM = 1024, CTXL = 256;
constexpr int ML = NB * SEQ, MC = NB * CTXL, MT = ML + MC, TALL = SEQ + CTXL;
constexpr int INW = 6656, DFF = 2816, NE = 8;
constexpr float EPS = 1e-6f;
constexpr int NWAVES = 8, NTHREADS = 512;

constexpr size_t MiB = 1u << 20, HMiB = 1u << 19;
constexpr size_t WS_CTL = 0, CTL_ZERO_BYTES = 64 * 1024;
constexpr size_t WS_MOD = 1 * MiB;
constexpr size_t WS_ROPE = 1 * MiB + 512 * 1024;
constexpr size_t WS_LAM = WS_ROPE + 16384;
constexpr size_t WS_TKE = 2 * MiB;
constexpr size_t WS_TKP = 2 * MiB + 256 * 1024;
constexpr size_t WS_PSLOT = 2 * MiB + 512 * 1024;
constexpr size_t WS_ROWMAP = 2 * MiB + 768 * 1024;
constexpr size_t WS_CNT = 3 * MiB + 256 * 1024;
constexpr size_t WS_PEXP = 3 * MiB + 320 * 1024;
constexpr size_t WS_Y = 4 * MiB;
constexpr size_t WS_WIN1 = 12 * MiB, WS_WM1 = 25 * MiB, WS_WO1 = 28 * MiB;
constexpr size_t WS_WIN0 = 30 * MiB, WS_WM0 = 43 * MiB, WS_WO0 = 46 * MiB, WS_WGU = 48 * MiB, WS_WD = 59 * MiB;
constexpr size_t WS_Q = 64 * MiB + HMiB, WS_K = WS_Q + 34 * MiB, WS_V = WS_K + 34 * MiB;
constexpr size_t WS_CB = WS_V + 34 * MiB, WS_U = WS_CB + 34 * MiB, WS_PIN = WS_U + 34 * MiB;
constexpr size_t WS_GT = WS_PIN + 34 * MiB;
constexpr size_t WS_H = WS_GT + 204 * MiB;
constexpr size_t WS_AO = WS_H, WS_P = WS_H + 34 * MiB;
constexpr size_t WS_END = WS_H + 68 * MiB;
constexpr size_t WS_MERGED = WS_Q;
constexpr size_t WS_MIX = WS_U;
constexpr size_t WS_H2_0 = WS_GT;
constexpr size_t WS_F_0 = WS_GT + 68 * MiB;
constexpr size_t WS_ACT0 = WS_Q;
constexpr size_t WS_WMOE = WS_GT + 72 * MiB;
constexpr size_t MOE_ESTRIDE = 16 * MiB + HMiB, MOE_WD_OFF = 11 * MiB;
constexpr size_t WS_ACT1 = 30 * MiB;
constexpr size_t WS_OUTP = 206 * MiB;
static_assert(WS_OUTP + 132 * MiB <= WS_WMOE && WS_ACT1 + 176 * MiB <= WS_OUTP && WS_WMOE + 132 * MiB <= WS_H, "moe map");
static_assert(WS_ACT0 + (size_t)MT * DFF * 2 <= WS_H2_0, "dense act map");

constexpr int CW_TMO = 0;
constexpr int CW_BAR = 1024;

constexpr int RING_BYTES = 131072;
constexpr int MISC_OFF = RING_BYTES + 320;
constexpr int LDS_BYTES = 147456;

#define LDS_WAIT() asm volatile("s_waitcnt lgkmcnt(0)" ::: "memory")
#define VM_WAIT() asm volatile("s_waitcnt vmcnt(0)" ::: "memory")
__device__ __forceinline__ unsigned cvt_pk_bf16(float lo, float hi) { unsigned r; asm volatile("v_cvt_pk_bf16_f32 %0, %1, %2" : "=v"(r) : "v"(lo), "v"(hi)); return r; }
__device__ __forceinline__ float bf_lo(unsigned u) { return __uint_as_float(u << 16); }
__device__ __forceinline__ float bf_hi(unsigned u) { return __uint_as_float(u & 0xffff0000u); }
__device__ __forceinline__ float wave_sum(float v) {
#pragma unroll
    for (int o = 1; o < 64; o <<= 1) v += __shfl_xor(v, o);
    return v;
}
__device__ __forceinline__ float fast_rcp(float x) { return __builtin_amdgcn_rcpf(x); }
__device__ __forceinline__ float sigmoid_c(float x) { x = fminf(fmaxf(x, -30.f), 30.f); return fast_rcp(1.f + __builtin_amdgcn_exp2f(-1.4426950408889634f * x)); }
__device__ __forceinline__ float silu_f(float x) { return x * fast_rcp(1.f + __builtin_amdgcn_exp2f(-1.4426950408889634f * x)); }

#define XB_TMO      128
#define XB_XCNT(j)  (256  + 64 * (j))
#define XB_XSUB(j)  (1280 + 64 * (j))
#define XB_XGEN(j)  (2304 + 64 * (j))
#define XB_TOP      3328
#define XB_TOPGEN   3392
#define XCD_BAR_WORDS 3456
#define XB_SPIN_CAP (1u << 20)
__device__ __forceinline__ unsigned xb_ld(unsigned* p)              { return __hip_atomic_load(p, __ATOMIC_RELAXED, __HIP_MEMORY_SCOPE_AGENT); }
__device__ __forceinline__ unsigned xb_add(unsigned* p, unsigned v) { return __hip_atomic_fetch_add(p, v, __ATOMIC_RELAXED, __HIP_MEMORY_SCOPE_AGENT); }
__device__ __forceinline__ unsigned xb_xcc_id() { return (unsigned)__builtin_amdgcn_s_getreg((3 << 11) | 20) & 0xFu; }
#define XB_SPIN(cond, bar) do { unsigned _sp = 0; while (cond) { __builtin_amdgcn_s_sleep(1); \
    if ((++_sp & 255u) == 0u) { if (xb_ld(&(bar)[XB_TMO])) break; if (_sp > XB_SPIN_CAP) { atomicAdd(&(bar)[XB_TMO], 1u); break; } } } } while (0)
struct XcdBarrier { unsigned* bar; unsigned x; volatile LAS unsigned* st; };
__device__ __forceinline__ XcdBarrier xcd_barrier_post(unsigned* bar, volatile LAS unsigned* st) {
    XcdBarrier b; b.bar = bar; b.x = xb_xcc_id(); b.st = st;
    if (threadIdx.x == 0) (void)xb_add(&bar[XB_XCNT(b.x)], 1u);
    return b;
}
__device__ __forceinline__ void xcd_barrier_complete(unsigned* bar, unsigned x, unsigned& nloc, unsigned& nx) {
    const unsigned G = gridDim.x * gridDim.y * gridDim.z;
    unsigned sum, cnt, mine, sp = 0u;
    for (;;) {
        sum = 0u; cnt = 0u; mine = 0u;
#pragma unroll
        for (unsigned j = 0; j < 16; ++j) { const unsigned c = xb_ld(&bar[XB_XCNT(j)]); sum += c; cnt += (c > 0u) ? 1u : 0u; mine = (j == x) ? c : mine; }
        if (sum == G) break;
        __builtin_amdgcn_s_sleep(1);
        if ((++sp & 255u) == 0u) { if (xb_ld(&bar[XB_TMO])) break; if (sp > XB_SPIN_CAP) { atomicAdd(&bar[XB_TMO], 1u); break; } }
    }
    nloc = mine > 0u ? mine : 1u; nx = cnt > 0u ? cnt : 1u;
}
__device__ __forceinline__ void xcd_barrier(const XcdBarrier& b) {
    asm volatile("s_waitcnt vmcnt(0)" ::: "memory");
    __syncthreads();
    if (threadIdx.x == 0) {
        unsigned* bar = b.bar;
        __builtin_amdgcn_s_waitcnt(0);
        unsigned nloc = b.st[0], nx = b.st[1];
        if (nloc == 0u) { xcd_barrier_complete(bar, b.x, nloc, nx); b.st[0] = nloc; b.st[1] = nx; }
        const unsigned old = xb_add(&bar[XB_XSUB(b.x)], 1u);
        const unsigned gen = old / nloc;
        if (old + 1u == (gen + 1u) * nloc) {
            __builtin_amdgcn_fence(__ATOMIC_RELEASE, "agent");
            asm volatile("s_waitcnt vmcnt(0)" ::: "memory");
            const unsigned og = xb_add(&bar[XB_TOP], 1u);
            const unsigned tg = og / nx;
            if (og + 1u == (tg + 1u) * nx) xb_add(&bar[XB_TOPGEN], 1u);
            else XB_SPIN(xb_ld(&bar[XB_TOPGEN]) == tg, bar);
            __builtin_amdgcn_fence(__ATOMIC_ACQUIRE, "agent");
            xb_add(&bar[XB_XGEN(b.x)], 1u);
            asm volatile("s_waitcnt vmcnt(0)" ::: "memory");
        } else {
            XB_SPIN(xb_ld(&bar[XB_XGEN(b.x)]) == gen, bar);
            __builtin_amdgcn_fence(__ATOMIC_ACQUIRE, "agent");
            asm volatile("s_waitcnt vmcnt(0)" ::: "memory");
        }
    }
    __syncthreads();
}

namespace pg8 {
constexpr int BM = 256, BK = 64, HALF = 128, HTB = HALF * BK * 2, STAGE_BYTES = 8 * HTB, NXCD = 8, WGM = 8;
__device__ __forceinline__ int lds_byte(int r, int c) { const int st = (r >> 4) * 2 + (c >> 5), rr = r & 15, cc = c & 31, ob = rr * 64 + cc * 2; return st * 1024 + (ob ^ (((ob >> 9) & 1) << 5)); }
__device__ __forceinline__ void stage_rc(int b, int& R, int& C) { const int st = b / 1024, sb = b % 1024, swz = sb ^ (((sb >> 9) & 1) << 5); R = (st >> 1) * 16 + swz / 64; C = (st & 1) * 32 + (swz % 64) / 2; }
__device__ __forceinline__ int perm32(int rho) { const int n = rho >> 4, i = rho & 15; return 8 * (i >> 2) + 4 * n + (i & 3); }

struct Unit { int pm, pn, aux; const char* A; const char* B; };

struct TileOrder {
    int nM, nN, nwg, G, c;
    __device__ __forceinline__ void init(int nM_, int nN_, int G_, int c_) { nM = nM_; nN = nN_; nwg = nM * nN; G = G_; c = c_; }
    __device__ __forceinline__ void tile(int L, int& pm, int& pn) const {
        int wgid = L; { const int q = nwg / NXCD, r = nwg % NXCD, xcd = wgid % NXCD, off = wgid / NXCD; wgid = (xcd < r ? xcd * (q + 1) : r * (q + 1) + (xcd - r) * q) + off; }
        const int nig = WGM * nN, gid = wgid / nig, fm = gid * WGM, gsz = (nM - fm) < WGM ? (nM - fm) : WGM;
        pm = fm + ((wgid % nig) % gsz); pn = (wgid % nig) / gsz;
    }
};

template <class Epi, class Sched, bool KSEG, bool GATHER>
__device__ __forceinline__ void gemm_phase(LAS unsigned char* lds, const int K, const int lda, const int ldb, const Sched& S, const Epi& E,
                                           const long segoff1, const long segoff2, const int* __restrict__ rowmap) {
    int tid = threadIdx.x; asm volatile("" : "+v"(tid));
    const int wid = __builtin_amdgcn_readfirstlane(tid >> 6), lane = tid & 63, wr = wid >> 2, wc = wid & 3, fr = lane & 15, fq = lane >> 4;
    const int nt = K / BK;
    int Rr[2], Cc[2];
    unsigned voffB[2], vaC[2][2], vaN[2][2];
    const size_t hstepB = (size_t)HALF * ldb * 2;
#pragma unroll
    for (int i = 0; i < 2; ++i) { stage_rc(tid * 16 + i * 8192, Rr[i], Cc[i]); const int Rb = (Rr[i] & ~31) + perm32(Rr[i] & 31);
        voffB[i] = (unsigned)(Rb * ldb + Cc[i]) * 2u;
#pragma unroll
        for (int h = 0; h < 2; ++h) { vaC[h][i] = (unsigned)((h * HALF + Rr[i]) * lda + Cc[i]) * 2u; vaN[h][i] = vaC[h][i]; } }
    const unsigned ldsw = (unsigned)wid * 1024u;
    const int aoff = lds_byte(wr * 64 + fr, fq * 8), boff = lds_byte(wc * 32 + fr, fq * 8);
#define PG8_SA(b, h) (((b) * 2 + (h)) * HTB)
#define PG8_SB(b, h) ((4 + (b) * 2 + (h)) * HTB)
#define PG8_STAGE(bufoff, gbase, voff) do { _Pragma("unroll") for (int _i = 0; _i < 2; ++_i) \
        __builtin_amdgcn_global_load_lds((const unsigned*)((const char*)(gbase) + (voff)[_i]), (LAS unsigned*)(lds + (bufoff) + ldsw + _i * 8192), 16, 0, 0); } while (0)
#define PG8_LDA(dst, b, h) do { _Pragma("unroll") for (int m = 0; m < 4; ++m) _Pragma("unroll") for (int k = 0; k < 2; ++k) dst[m][k] = *(const LAS bf16x8*)(lds + PG8_SA(b, h) + aoff + m * 2048 + k * 1024); } while (0)
#define PG8_LDB(dst, b, h) do { _Pragma("unroll") for (int n = 0; n < 2; ++n) _Pragma("unroll") for (int k = 0; k < 2; ++k) dst[n][k] = *(const LAS bf16x8*)(lds + PG8_SB(b, h) + boff + n * 2048 + k * 1024); } while (0)
#define PG8_MMA(ai, bj, At, Bt) do { __builtin_amdgcn_s_setprio(1); _Pragma("unroll") for (int m = 0; m < 4; ++m) _Pragma("unroll") for (int n = 0; n < 2; ++n) _Pragma("unroll") for (int k = 0; k < 2; ++k) \
        acc[ai][bj][m][n] = __builtin_amdgcn_mfma_f32_16x16x32_bf16(Bt[n][k], At[m][k], acc[ai][bj][m][n], 0, 0, 0); __builtin_amdgcn_s_setprio(0); } while (0)
#define PG8_WAIT_V(n) asm volatile("s_waitcnt vmcnt(" #n ")" ::: "memory")
#define PG8_WAIT_L(n) asm volatile("s_waitcnt lgkmcnt(" #n ")" ::: "memory")
#define PG8_BAR __builtin_amdgcn_s_barrier()
#define PG8_SCHED __builtin_amdgcn_sched_barrier(0)
#define PG8_KOFF(t) (KSEG ? ((long)(((t) >> 3) == 0 ? 0L : (((t) >> 3) == 1 ? segoff1 : segoff2)) + (long)((t) & 7) * 128L) : (long)(t) * 128L)
#define PG8_GATHER(dst, u) do { if constexpr (GATHER) { _Pragma("unroll") for (int _h = 0; _h < 2; ++_h) _Pragma("unroll") for (int _i = 0; _i < 2; ++_i) \
        dst[_h][_i] = (unsigned)(rowmap[(u).aux * 256 + _h * HALF + Rr[_i]] * lda + Cc[_i]) * 2u; } } while (0)
    Unit cur, nxt; int ui = 0;
    if (!S.next(0, cur)) return;
    f32x4 acc[2][2][4][2];
#pragma unroll
    for (int a = 0; a < 2; ++a)
#pragma unroll
        for (int b = 0; b < 2; ++b)
#pragma unroll
            for (int m = 0; m < 4; ++m)
#pragma unroll
                for (int n = 0; n < 2; ++n) acc[a][b][m][n] = (f32x4){0.f, 0.f, 0.f, 0.f};
    bf16x8 At[4][2], B0[2][2], B1[2][2];
    const char* cA = cur.A; const char* cB = cur.B;
    PG8_GATHER(vaC, cur);
    PG8_STAGE(PG8_SB(0, 0), cB, voffB); PG8_STAGE(PG8_SB(0, 1), cB + hstepB, voffB); PG8_STAGE(PG8_SA(0, 0), cA, vaC[0]); PG8_STAGE(PG8_SA(0, 1), cA, vaC[1]);
    if (wr == 1) PG8_BAR;
    PG8_WAIT_V(2); PG8_BAR;
    PG8_STAGE(PG8_SB(1, 0), cB + 128, voffB); PG8_STAGE(PG8_SA(1, 0), cA + PG8_KOFF(1), vaC[0]); PG8_STAGE(PG8_SB(1, 1), cB + hstepB + 128, voffB);
    PG8_WAIT_V(6); PG8_BAR;
    for (;;) {
        const bool has_next = S.next(ui + 1, nxt);
        const char* nA = has_next ? nxt.A : cA; const char* nB = has_next ? nxt.B : cB;
        if constexpr (GATHER) { if (has_next) { PG8_GATHER(vaN, nxt); } else {
#pragma unroll
            for (int h = 0; h < 2; ++h)
#pragma unroll
                for (int i = 0; i < 2; ++i) vaN[h][i] = vaC[h][i]; } }
        const int tchunk = Epi::MIDK ? 8 : nt;
        for (int t0 = 0; t0 < nt; t0 += tchunk) {
        if constexpr (Epi::MIDK) { if (t0 > 0) { PG8_SCHED; E.rescale(acc, cur, (t0 >> 3) - 1, wr, wc, fr, fq); PG8_SCHED; } }
        for (int t = t0; t < t0 + tchunk; t += 2) {
            const bool last = (t == nt - 2);
            const char* a1 = cA + PG8_KOFF(t + 1);
            const char* a2 = last ? nA : cA + PG8_KOFF(t + 2); const char* b2 = last ? nB : cB + (size_t)(t + 2) * 128;
            const char* a3 = last ? nA + PG8_KOFF(1) : cA + PG8_KOFF(t + 3); const char* b3 = b2 + 128;
            unsigned v20[2], v21[2];
#pragma unroll
            for (int i = 0; i < 2; ++i) { v20[i] = (GATHER && last) ? vaN[0][i] : vaC[0][i]; v21[i] = (GATHER && last) ? vaN[1][i] : vaC[1][i]; }
            PG8_LDB(B0, 0, 0); PG8_LDB(B1, 0, 1); PG8_SCHED; PG8_LDA(At, 0, 0); PG8_STAGE(PG8_SA(1, 1), a1, vaC[1]);
            PG8_WAIT_V(8); PG8_WAIT_L(0); PG8_BAR; PG8_MMA(0, 0, At, B0); PG8_MMA(0, 1, At, B1); PG8_BAR; PG8_SCHED;
            PG8_LDA(At, 0, 1); PG8_STAGE(PG8_SB(0, 0), b2, voffB); PG8_STAGE(PG8_SB(0, 1), b2 + hstepB, voffB); PG8_STAGE(PG8_SA(0, 0), a2, v20);
            PG8_WAIT_V(8); PG8_WAIT_L(0); PG8_BAR; PG8_MMA(1, 0, At, B0); PG8_MMA(1, 1, At, B1); PG8_BAR; PG8_SCHED;
            PG8_LDB(B0, 1, 0); PG8_LDB(B1, 1, 1); PG8_SCHED; PG8_LDA(At, 1, 0); PG8_STAGE(PG8_SA(0, 1), a2, v21);
            PG8_WAIT_V(8); PG8_WAIT_L(0); PG8_BAR; PG8_MMA(0, 0, At, B0); PG8_MMA(0, 1, At, B1); PG8_BAR; PG8_SCHED;
            PG8_LDA(At, 1, 1); PG8_STAGE(PG8_SB(1, 0), b3, voffB); PG8_STAGE(PG8_SB(1, 1), b3 + hstepB, voffB); PG8_STAGE(PG8_SA(1, 0), a3, v20);
            PG8_WAIT_V(8); PG8_WAIT_L(0); PG8_BAR; PG8_MMA(1, 0, At, B0); PG8_MMA(1, 1, At, B1); PG8_BAR; PG8_SCHED;
        }
        }
        if (wr == 0) PG8_BAR;
        E(acc, cur, wr, wc, fr, fq);
        if (!has_next) break;
#pragma unroll
        for (int a = 0; a < 2; ++a)
#pragma unroll
            for (int b = 0; b < 2; ++b)
#pragma unroll
                for (int m = 0; m < 4; ++m)
#pragma unroll
                    for (int n = 0; n < 2; ++n) acc[a][b][m][n] = (f32x4){0.f, 0.f, 0.f, 0.f};
        cur = nxt; cA = nA; cB = nB; ++ui;
        if constexpr (GATHER) {
#pragma unroll
            for (int h = 0; h < 2; ++h)
#pragma unroll
                for (int i = 0; i < 2; ++i) vaC[h][i] = vaN[h][i]; }
        if (wr == 1) PG8_BAR;
    }
    PG8_WAIT_V(0);
    PG8_BAR;
#undef PG8_SA
#undef PG8_SB
#undef PG8_STAGE
#undef PG8_LDA
#undef PG8_LDB
#undef PG8_MMA
#undef PG8_WAIT_V
#undef PG8_WAIT_L
#undef PG8_BAR
#undef PG8_SCHED
#undef PG8_KOFF
#undef PG8_GATHER
}

struct SchedG {
    TileOrder o; const char* A; const char* B; int astep, bstep; int nx;
    __device__ __forceinline__ bool next(int i, Unit& u) const {
        const long L = (long)i * o.G + o.c;
        if (L < o.nwg) { o.tile((int)L, u.pm, u.pn); }
        else { const int x = (int)(L - o.nwg); if (x >= nx) return false; u.pm = 128 + (x >> 2); u.pn = 2 + (x & 3); }
        u.aux = u.pm; u.A = A + (size_t)u.pm * astep; u.B = B + (size_t)u.pn * bstep; return true;
    }
};
struct SchedMoe {
    TileOrder o; int p0; const int* pexp; const char* A; int astep; const char* B; int estride, bstep;
    __device__ __forceinline__ bool next(int i, Unit& u) const {
        const long L = (long)i * o.G + o.c;
        if (L >= o.nwg) return false;
        o.tile((int)L, u.pm, u.pn);
        const int e = __builtin_amdgcn_readfirstlane(pexp[p0 + u.pm]);
        u.aux = p0 + u.pm; u.A = A + (size_t)u.pm * astep; u.B = B + (size_t)e * estride + (size_t)u.pn * bstep; return true;
    }
};

typedef f32x4 Acc[2][2][4][2];
__device__ __forceinline__ u32x4 pack8(const f32x4 v0, const f32x4 v1) { u32x4 w; w.x = cvt_pk_bf16(v0[0], v0[1]); w.y = cvt_pk_bf16(v0[2], v0[3]); w.z = cvt_pk_bf16(v1[0], v1[1]); w.w = cvt_pk_bf16(v1[2], v1[3]); return w; }

struct EpiZ {
    static constexpr bool MIDK = false;
    unsigned char* ws;
    __device__ __forceinline__ void rescale(Acc&, const Unit&, int, int, int, int, int) const {}
    __device__ __forceinline__ void operator()(const Acc& acc, const Unit& u, int wr, int wc, int fr, int fq) const {
        const int pm = u.pm, pn = u.pn; const bool isctx = pm >= 128;
        bf16_t* const Q = (bf16_t*)(ws + WS_Q); bf16_t* const Kb = (bf16_t*)(ws + WS_K); bf16_t* const Vb = (bf16_t*)(ws + WS_V); bf16_t* const CB = (bf16_t*)(ws + WS_CB);
        bf16_t* const U = (bf16_t*)(ws + WS_U); bf16_t* const PIN = (bf16_t*)(ws + WS_PIN); bf16_t* const GT = (bf16_t*)(ws + WS_GT);
        const float* const ropeC = (const float*)(ws + WS_ROPE); const float* const ropeS = ropeC + 1024;
        int mode, pitch = 512, colt; bf16_t* base; bool krow = false;
        if (pn < 2) { mode = isctx ? 0 : 1; base = Q; colt = 256 * pn; }
        else if (pn < 4) { mode = isctx ? 0 : 1; base = Kb; colt = 256 * (pn - 2); krow = true; }
        else if (pn < 6) { mode = 0; base = Vb; colt = 256 * (pn - 4); krow = true; }
        else if (pn < 8) { mode = 0; base = CB; colt = 256 * (pn - 6); }
        else if (pn < 12) { mode = 2; base = U; colt = 128 * (pn - 8); }
        else if (pn < 14) { mode = 0; base = PIN; colt = 256 * (pn - 12); }
        else { mode = 3; base = GT; pitch = 3072; colt = 256 * (pn - 14); }
        const long rowbase = krow ? (isctx ? (long)(pm - 128) * TALL : (long)(pm >> 4) * TALL + CTXL + (pm & 15) * 256) : (long)pm * 256;
        const int cl = wc * 32 + 8 * fq;
#pragma unroll
        for (int ai = 0; ai < 2; ++ai)
#pragma unroll
            for (int m = 0; m < 4; ++m) {
                const int rl = ai * 128 + wr * 64 + m * 16 + fr;
                bf16_t* rowp = base + (size_t)(rowbase + rl) * pitch + colt + cl;
                if (mode == 2) {
                    const f32x4 a0 = acc[ai][0][m][0] * acc[ai][1][m][0], a1 = acc[ai][0][m][1] * acc[ai][1][m][1];
                    *(u32x4*)rowp = pack8(a0, a1);
                } else if (mode == 1) {
                    const int pos = (wc & 1) ? (m * 16 + fr) : ((pm & 15) * 4 + 2 * ai + wr);
                    const f32x4 cs = *(const f32x4*)(ropeC + pos * 16 + 4 * fq), sn = *(const f32x4*)(ropeS + pos * 16 + 4 * fq);
#pragma unroll
                    for (int bj = 0; bj < 2; ++bj) { const f32x4 v0 = acc[ai][bj][m][0], v1 = acc[ai][bj][m][1];
                        *(u32x4*)(rowp + bj * 128) = pack8(v0 * cs - v1 * sn, v1 * cs + v0 * sn); }
                } else if (mode == 3) {
#pragma unroll
                    for (int bj = 0; bj < 2; ++bj) { f32x4 v0 = acc[ai][bj][m][0], v1 = acc[ai][bj][m][1];
#pragma unroll
                        for (int j = 0; j < 4; ++j) { v0[j] = sigmoid_c(v0[j]); v1[j] = sigmoid_c(v1[j]); }
                        *(u32x4*)(rowp + bj * 128) = pack8(v0, v1); }
                } else {
#pragma unroll
                    for (int bj = 0; bj < 2; ++bj) *(u32x4*)(rowp + bj * 128) = pack8(acc[ai][bj][m][0], acc[ai][bj][m][1]);
                }
                asm volatile("" ::: "memory");
            }
    }
};
struct EpiPlain {
    static constexpr bool MIDK = false;
    bf16_t* O; int ldc;
    __device__ __forceinline__ void rescale(Acc&, const Unit&, int, int, int, int, int) const {}
    __device__ __forceinline__ void operator()(const Acc& acc, const Unit& u, int wr, int wc, int fr, int fq) const {
        const int cl = u.pn * 256 + wc * 32 + 8 * fq;
#pragma unroll
        for (int ai = 0; ai < 2; ++ai)
#pragma unroll
            for (int m = 0; m < 4; ++m) { bf16_t* rowp = O + (size_t)(u.pm * 256 + ai * 128 + wr * 64 + m * 16 + fr) * ldc + cl;
#pragma unroll
                for (int bj = 0; bj < 2; ++bj) *(u32x4*)(rowp + bj * 128) = pack8(acc[ai][bj][m][0], acc[ai][bj][m][1]); }
    }
};
struct EpiGlu {
    static constexpr bool MIDK = false;
    bf16_t* O;
    __device__ __forceinline__ void rescale(Acc&, const Unit&, int, int, int, int, int) const {}
    __device__ __forceinline__ void operator()(const Acc& acc, const Unit& u, int wr, int wc, int fr, int fq) const {
        const int cl = u.pn * 128 + wc * 32 + 8 * fq;
#pragma unroll
        for (int ai = 0; ai < 2; ++ai)
#pragma unroll
            for (int m = 0; m < 4; ++m) { bf16_t* rowp = O + (size_t)(u.pm * 256 + ai * 128 + wr * 64 + m * 16 + fr) * DFF + cl;
                f32x4 g0 = acc[ai][0][m][0], g1 = acc[ai][0][m][1];
#pragma unroll
                for (int j = 0; j < 4; ++j) { g0[j] = silu_f(g0[j]); g1[j] = silu_f(g1[j]); }
                *(u32x4*)rowp = pack8(g0 * acc[ai][1][m][0], g1 * acc[ai][1][m][1]); }
    }
};
struct EpiMerge {
    static constexpr bool MIDK = true;
    bf16_t* O; const bf16_t* GT;
    __device__ __forceinline__ void rescale(Acc& acc, const Unit& u, int j, int wr, int wc, int fr, int fq) const {
        const int cl = u.pn * 256 + wc * 32 + 8 * fq;
#pragma unroll
        for (int ai = 0; ai < 2; ++ai)
#pragma unroll
            for (int m = 0; m < 4; ++m) { const bf16_t* gp = GT + (size_t)(u.pm * 256 + ai * 128 + wr * 64 + m * 16 + fr) * 3072 + j * 1024 + cl;
#pragma unroll
                for (int bj = 0; bj < 2; ++bj) { const u32x4 a = *(const u32x4*)(gp + bj * 128), b = *(const u32x4*)(gp + 1024 + bj * 128);
                    f32x4 r0, r1;
                    r0[0] = bf_lo(a.x) * fast_rcp(bf_lo(b.x)); r0[1] = bf_hi(a.x) * fast_rcp(bf_hi(b.x)); r0[2] = bf_lo(a.y) * fast_rcp(bf_lo(b.y)); r0[3] = bf_hi(a.y) * fast_rcp(bf_hi(b.y));
                    r1[0] = bf_lo(a.z) * fast_rcp(bf_lo(b.z)); r1[1] = bf_hi(a.z) * fast_rcp(bf_hi(b.z)); r1[2] = bf_lo(a.w) * fast_rcp(bf_lo(b.w)); r1[3] = bf_hi(a.w) * fast_rcp(bf_hi(b.w));
                    acc[ai][bj][m][0] *= r0; acc[ai][bj][m][1] *= r1; }
                asm volatile("" ::: "memory"); }
    }
    __device__ __forceinline__ void operator()(const Acc& acc, const Unit& u, int wr, int wc, int fr, int fq) const {
        const int cl = u.pn * 256 + wc * 32 + 8 * fq;
#pragma unroll
        for (int ai = 0; ai < 2; ++ai)
#pragma unroll
            for (int m = 0; m < 4; ++m) { const size_t row = (size_t)(u.pm * 256 + ai * 128 + wr * 64 + m * 16 + fr);
                const bf16_t* gp = GT + row * 3072 + 2048 + cl; bf16_t* rowp = O + row * 1024 + cl;
#pragma unroll
                for (int bj = 0; bj < 2; ++bj) { const u32x4 a = *(const u32x4*)(gp + bj * 128);
                    const f32x4 g0 = (f32x4){bf_lo(a.x), bf_hi(a.x), bf_lo(a.y), bf_hi(a.y)}, g1 = (f32x4){bf_lo(a.z), bf_hi(a.z), bf_lo(a.w), bf_hi(a.w)};
                    *(u32x4*)(rowp + bj * 128) = pack8(acc[ai][bj][m][0] * g0, acc[ai][bj][m][1] * g1); }
                asm volatile("" ::: "memory"); }
    }
};
}

namespace att {
constexpr int KVBLK = 64;
constexpr float SCALE = 0.125f, THR = 8.f;
constexpr int LDQ = 512;
constexpr size_t SHM_V = KVBLK * 128 * 2, SHM_K = KVBLK * 128 * 2;
#define KSWZ(row, colB) ((row) * 256 + ((colB) ^ (((row) & 7) << 4)))
#define SBAR() __builtin_amdgcn_sched_barrier(0)
__device__ __forceinline__ int crow(int r, int hi) { return (r & 3) + 8 * (r >> 2) + 4 * hi; }
__device__ __forceinline__ void partialSM(f32x16& p0, f32x16& p1, float& m_reg, float& mn, float& alpha) {
    constexpr float C = SCALE * 1.4426950408889634f;
    float pmax = p0[0];
#pragma unroll
    for (int r = 1; r < 16; ++r) pmax = fmaxf(pmax, p0[r]);
#pragma unroll
    for (int r = 0; r < 16; ++r) pmax = fmaxf(pmax, p1[r]);
    { auto rr = __builtin_amdgcn_permlane32_swap(__float_as_uint(pmax), __float_as_uint(pmax), false, false);
      pmax = fmaxf(__uint_as_float(rr[0]), __uint_as_float(rr[1])); }
    if (__builtin_expect(__all(pmax - m_reg <= THR / SCALE), 1)) { mn = m_reg; alpha = 1.f; }
    else { mn = fmaxf(m_reg, pmax); alpha = __builtin_amdgcn_exp2f((m_reg - mn) * C); m_reg = mn; }
    const float mnC = -mn * C;
#pragma unroll
    for (int r = 0; r < 16; ++r) p0[r] = fmaf(p0[r], C, mnC);
#pragma unroll
    for (int r = 0; r < 16; ++r) p1[r] = fmaf(p1[r], C, mnC);
#pragma unroll
    for (int r = 0; r < 16; ++r) p0[r] = __builtin_amdgcn_exp2f(p0[r]);
}
__device__ __forceinline__ void finishSM(f32x16& p0, f32x16& p1, float alpha, float& l_reg, bf16x8& pa0, bf16x8& pa1, bf16x8& pa2, bf16x8& pa3) {
#pragma unroll
    for (int r = 0; r < 16; ++r) p1[r] = __builtin_amdgcn_exp2f(p1[r]);
    float ps = 0;
#pragma unroll
    for (int r = 0; r < 16; ++r) ps += p0[r];
#pragma unroll
    for (int r = 0; r < 16; ++r) ps += p1[r];
    { auto rr = __builtin_amdgcn_permlane32_swap(__float_as_uint(ps), __float_as_uint(ps), false, false);
      ps = __uint_as_float(rr[0]) + __uint_as_float(rr[1]); }
    l_reg = l_reg * alpha + ps;
#define PK4(P, BASE, OUT) do { unsigned a0 = cvt_pk_bf16(P[BASE + 0], P[BASE + 1]), a1 = cvt_pk_bf16(P[BASE + 2], P[BASE + 3]);   \
    unsigned b0 = cvt_pk_bf16(P[BASE + 4], P[BASE + 5]), b1 = cvt_pk_bf16(P[BASE + 6], P[BASE + 7]);                              \
    auto r0 = __builtin_amdgcn_permlane32_swap(a0, b0, false, false); auto r1 = __builtin_amdgcn_permlane32_swap(a1, b1, false, false); \
    u32x4 w = {r0[0], r1[0], r0[1], r1[1]}; OUT = *reinterpret_cast<bf16x8*>(&w); } while (0)
    PK4(p0, 0, pa0); PK4(p0, 8, pa1); PK4(p1, 0, pa2); PK4(p1, 8, pa3);
#undef PK4
}
__device__ __forceinline__ void qkt(f32x16& p0, f32x16& p1, const char* Ks, const bf16x8* qr, int r32, int hi, int map) {
    p0 = f32x16{}; p1 = f32x16{};
#pragma unroll
    for (int d0 = 0; d0 < 4; ++d0) { const int cb = (map * 64 + d0 * 16 + hi * 8) * 2;
        const bf16x8 b0 = *reinterpret_cast<const bf16x8*>(Ks + KSWZ(r32, cb));
        const bf16x8 b1 = *reinterpret_cast<const bf16x8*>(Ks + KSWZ(32 + r32, cb));
        p0 = __builtin_amdgcn_mfma_f32_32x32x16_bf16(b0, qr[d0], p0, 0, 0, 0);
        p1 = __builtin_amdgcn_mfma_f32_32x32x16_bf16(b1, qr[d0], p1, 0, 0, 0); }
}
__device__ __forceinline__ int v_st(int k, int c) { const int kk = (k & ~0xC) | ((k & 4) << 1) | ((k & 8) >> 1); return ((kk >> 3) * 4 + (c >> 5)) * 512 + ((kk & 7) * 32 + (c & 31)) * 2; }
__device__ __forceinline__ int v_rd_base(int lane) { return ((lane & 3) << 3) | (((lane >> 2) & 3) << 6) | (((lane >> 4) & 1) << 5) | (((lane >> 5) & 1) << 8); }
constexpr int v_rd_off(int d0, int ks, int half) { return d0 * 512 + ks * 4096 + half * 2048; }
template <int OFF> __device__ __forceinline__ s16x4 tr_read(int vb) {
    s16x4 r; asm volatile("ds_read_b64_tr_b16 %0, %1 offset:%2" : "=&v"(r) : "v"(vb), "i"(OFF) : "memory"); return r;
}
template <int D0> __device__ __forceinline__ void pv_one(f32x16& od, int vb, bf16x8 pa0, bf16x8 pa1, bf16x8 pa2, bf16x8 pa3) {
    const s16x4 l0 = tr_read<v_rd_off(D0, 0, 0)>(vb), h0 = tr_read<v_rd_off(D0, 0, 1)>(vb), l1 = tr_read<v_rd_off(D0, 1, 0)>(vb), h1 = tr_read<v_rd_off(D0, 1, 1)>(vb);
    const s16x4 l2 = tr_read<v_rd_off(D0, 2, 0)>(vb), h2 = tr_read<v_rd_off(D0, 2, 1)>(vb), l3 = tr_read<v_rd_off(D0, 3, 0)>(vb), h3 = tr_read<v_rd_off(D0, 3, 1)>(vb);
    asm volatile("s_waitcnt lgkmcnt(0)" ::: "memory"); SBAR();
#define PK(L, H) (bf16x8){L[0], L[1], L[2], L[3], H[0], H[1], H[2], H[3]}
    od = __builtin_amdgcn_mfma_f32_32x32x16_bf16(pa0, PK(l0, h0), od, 0, 0, 0);
    od = __builtin_amdgcn_mfma_f32_32x32x16_bf16(pa1, PK(l1, h1), od, 0, 0, 0);
    od = __builtin_amdgcn_mfma_f32_32x32x16_bf16(pa2, PK(l2, h2), od, 0, 0, 0);
    od = __builtin_amdgcn_mfma_f32_32x32x16_bf16(pa3, PK(l3, h3), od, 0, 0, 0);
#undef PK
}
__device__ __forceinline__ void pv_d0(f32x16* o, int vb, bf16x8 pa0, bf16x8 pa1, bf16x8 pa2, bf16x8 pa3) {
    pv_one<0>(o[0], vb, pa0, pa1, pa2, pa3); pv_one<1>(o[1], vb, pa0, pa1, pa2, pa3); pv_one<2>(o[2], vb, pa0, pa1, pa2, pa3); pv_one<3>(o[3], vb, pa0, pa1, pa2, pa3);
}

__device__ __forceinline__ void attn_unit(const bf16_t* __restrict__ Qb, const bf16_t* __restrict__ Kh, const bf16_t* __restrict__ Vh, bf16_t* __restrict__ Ob,
                                          const int seq, const float lam, const float* __restrict__ gs, char* lds) {
    int tid = threadIdx.x; asm volatile("" : "+v"(tid));
    const int wid = tid >> 6, lane = tid & 63, r32 = lane & 31, hi = lane >> 5, map = wid >> 2, wq = wid & 3;
    char* V_lds = lds; char* K_lds = lds + 2 * SHM_V;
    float* ws = (float*)(lds + 2 * SHM_V + 2 * SHM_K) + wid * 64; float* li_l = ws; float* al_l = ws + 32;
    float m_reg = -1e30f, l_reg = 0; f32x16 o[4] = {}; bf16x8 qr[4];
    const bf16_t* Qw = Qb + (long)(wq * 32 + r32) * LDQ + map * 64 + hi * 8;
#pragma unroll
    for (int d0 = 0; d0 < 4; ++d0) qr[d0] = *reinterpret_cast<const bf16x8*>(Qw + d0 * 16);
    const int sr = tid >> 4, sc = (tid & 15) * 8, vst0 = v_st(sr, sc), vst1 = v_st(32 + sr, sc);
    const int vb0 = (int)(uintptr_t)V_lds + v_rd_base(lane);
    struct { bf16x8 vs0, vs1, ks0, ks1; } sr_[2];
#define SLOAD(i, k0) do { sr_[i].vs0 = *reinterpret_cast<const bf16x8*>(&Vh[(long)((k0) + sr) * 512 + sc]); sr_[i].vs1 = *reinterpret_cast<const bf16x8*>(&Vh[(long)((k0) + 32 + sr) * 512 + sc]); \
    sr_[i].ks0 = *reinterpret_cast<const bf16x8*>(&Kh[(long)((k0) + sr) * 512 + sc]); sr_[i].ks1 = *reinterpret_cast<const bf16x8*>(&Kh[(long)((k0) + 32 + sr) * 512 + sc]); } while (0)
#define SWRITE(b, i) do { *(bf16x8*)(V_lds + (b) * SHM_V + vst0) = sr_[i].vs0;          \
    *(bf16x8*)(V_lds + (b) * SHM_V + vst1) = sr_[i].vs1; const int kc = sc * 2;               \
    *(bf16x8*)(K_lds + (b) * SHM_K + KSWZ(sr, kc)) = sr_[i].ks0;                       \
    *(bf16x8*)(K_lds + (b) * SHM_K + KSWZ(32 + sr, kc)) = sr_[i].ks1; } while (0)
#define SWAIT() asm volatile("s_waitcnt vmcnt(4)" ::: "memory")
#define RESC(a) do { if (__any((a) < 1.f)) { if (hi == 0) al_l[r32] = (a); asm volatile("s_waitcnt lgkmcnt(0)" ::: "memory"); \
    _Pragma("unroll") for (int d = 0; d < 4; ++d) _Pragma("unroll") for (int r = 0; r < 16; ++r) o[d][r] *= al_l[crow(r, hi)]; } } while (0)
    f32x16 pA0, pA1, pB0, pB1; float mnA, mnB, alA, alB; bf16x8 pa0, pa1, pa2, pa3; const int NT = seq / KVBLK;
    constexpr int SE = 0, SO = 1;
    SLOAD(SE, 0); asm volatile("s_waitcnt vmcnt(0)" ::: "memory"); SWRITE(0, SE); __syncthreads();
    qkt(pA0, pA1, K_lds, qr, r32, hi, map); partialSM(pA0, pA1, m_reg, mnA, alA);
    SLOAD(SO, KVBLK); if (2 < NT) SLOAD(SE, 2 * KVBLK);
    SWAIT(); SWRITE(1, SO); __syncthreads();
    for (int j = 1; j + 1 < NT; j += 2) {
        SBAR(); qkt(pB0, pB1, K_lds + SHM_K, qr, r32, hi, map);
        finishSM(pA0, pA1, alA, l_reg, pa0, pa1, pa2, pa3); SBAR();
        SLOAD(SO, (j + 2) * KVBLK); SBAR();
        pv_d0(o, vb0, pa0, pa1, pa2, pa3); partialSM(pB0, pB1, m_reg, mnB, alB);
        __syncthreads(); SWAIT(); SWRITE(0, SE);
        RESC(alB); __syncthreads();
        SBAR(); qkt(pA0, pA1, K_lds, qr, r32, hi, map);
        finishSM(pB0, pB1, alB, l_reg, pa0, pa1, pa2, pa3); SBAR();
        if (j + 3 < NT) SLOAD(SE, (j + 3) * KVBLK); SBAR();
        pv_d0(o, vb0 + (int)SHM_V, pa0, pa1, pa2, pa3); partialSM(pA0, pA1, m_reg, mnA, alA);
        __syncthreads(); SWAIT(); SWRITE(1, SO);
        RESC(alA); __syncthreads();
    }
    SBAR(); qkt(pB0, pB1, K_lds + SHM_K, qr, r32, hi, map);
    finishSM(pA0, pA1, alA, l_reg, pa0, pa1, pa2, pa3); SBAR();
    pv_d0(o, vb0, pa0, pa1, pa2, pa3); partialSM(pB0, pB1, m_reg, mnB, alB);
    __syncthreads(); RESC(alB);
    finishSM(pB0, pB1, alB, l_reg, pa0, pa1, pa2, pa3); SBAR();
    pv_d0(o, vb0 + (int)SHM_V, pa0, pa1, pa2, pa3);
    if (hi == 0) li_l[r32] = l_reg; asm volatile("s_waitcnt lgkmcnt(0)" ::: "memory");
    float rli[16];
#pragma unroll
    for (int r = 0; r < 16; ++r) rli[r] = 1.0f / li_l[crow(r, hi)];
#pragma unroll
    for (int d0 = 0; d0 < 4; ++d0)
#pragma unroll
        for (int r = 0; r < 16; ++r) o[d0][r] *= rli[r];
    __syncthreads();
    float* X = (float*)lds + wq * (32 * 128);
    if (map == 1) {
#pragma unroll
        for (int d0 = 0; d0 < 4; ++d0)
#pragma unroll
            for (int r = 0; r < 16; ++r) X[crow(r, hi) * 128 + d0 * 32 + r32] = o[d0][r];
    }
    __syncthreads();
    if (map == 0) {
#pragma unroll
        for (int d0 = 0; d0 < 4; ++d0)
#pragma unroll
            for (int r = 0; r < 16; ++r) o[d0][r] -= lam * X[crow(r, hi) * 128 + d0 * 32 + r32];
        float g4[4];
#pragma unroll
        for (int d0 = 0; d0 < 4; ++d0) g4[d0] = gs[d0 * 32 + r32];
#pragma unroll
        for (int r = 0; r < 16; ++r) {
            float ss = o[0][r] * o[0][r] + o[1][r] * o[1][r] + o[2][r] * o[2][r] + o[3][r] * o[3][r];
            ss += __shfl_xor(ss, 1); ss += __shfl_xor(ss, 2); ss += __shfl_xor(ss, 4); ss += __shfl_xor(ss, 8); ss += __shfl_xor(ss, 16);
            const float rstd = 1.0f / sqrtf(ss * (1.0f / 128.0f) + EPS);
            bf16_t* op = Ob + (long)(wq * 32 + crow(r, hi)) * 512 + r32;
#pragma unroll
            for (int d0 = 0; d0 < 4; ++d0) op[d0 * 32] = (bf16_t)(cvt_pk_bf16(o[d0][r] * rstd * g4[d0], 0.f) & 0xffffu);
        }
    }
    __syncthreads();
#undef SLOAD
#undef SWRITE
#undef SWAIT
#undef RESC
}
#undef KSWZ
}

struct Args { const float* in[28]; float* out; unsigned char* ws; int ph_lo, ph_hi; };

struct Frame {
    LAS unsigned char* lds; volatile LAS unsigned* MISC;
    int c, G;
    float* out; unsigned char* ws;
};
template <int I> __device__ __forceinline__ const float* inp() {
    unsigned long long p;
    asm volatile("s_load_dwordx2 %0, %1, %2\n\ts_waitcnt lgkmcnt(0)" : "=s"(p) : "s"(__builtin_amdgcn_kernarg_segment_ptr()), "n"(I * 8));
    return (const float*)(const GAS float*)p;
}
enum { I_X = 0, I_C, I_CTX, I_CCTX, I_WMOD, I_BMOD, I_GPREMIX, I_GPOSTMIX, I_GPREFFN, I_GPOSTFFN, I_WIN, I_LQ1, I_LK1, I_LQ2, I_LK2, I_GSUB, I_CONVW, I_POOLW, I_POOLS,
       I_WBR, I_WOUT, I_FG, I_FU, I_FD, I_RW, I_MG, I_MU, I_MD };

__device__ __forceinline__ int rowmap_f(int kind, int off, int n) {
    if (kind == 0) return n + off;
    if (kind == 2) return ((n >> 7) << 8) + off + (n & 127);
    if (n < 1024) { const int ch = n >> 6, o = n & 63, a = o >> 5, hh = (o >> 4) & 1, f = o & 15; return ch * 64 + a * 32 + 8 * (f >> 2) + 4 * hh + (f & 3); }
    if (n >= 2048 && n < 3072) { const int x = n - 2048, isx = x >> 9, chn = x & 511; return 2048 + ((chn >> 7) << 8) + isx * 128 + (chn & 127); }
    return n;
}
__device__ __forceinline__ void tr_item(const float* __restrict__ W, int N, int k0, int n0, bf16_t* __restrict__ WT, int ldt, int kc0, int kind, int off, LAS float* scr, int lane) {
#pragma unroll 8
    for (int i = 0; i < 32; ++i) { const int kk = 2 * i + (lane >> 5); scr[kk * 33 + (lane & 31)] = W[(size_t)(k0 + kk) * N + n0 + (lane & 31)]; }
    LDS_WAIT(); asm volatile("" ::: "memory");
    const int c = lane & 7;
#pragma unroll
    for (int j = 0; j < 4; ++j) { const int n = (lane >> 3) + 8 * j; const LAS float* s = scr + (8 * c) * 33 + n;
        u32x4 o; o.x = cvt_pk_bf16(s[0 * 33], s[1 * 33]); o.y = cvt_pk_bf16(s[2 * 33], s[3 * 33]); o.z = cvt_pk_bf16(s[4 * 33], s[5 * 33]); o.w = cvt_pk_bf16(s[6 * 33], s[7 * 33]);
        *(u32x4*)(WT + (size_t)rowmap_f(kind, off, n0 + n) * ldt + kc0 + k0 + 8 * c) = o; }
    LDS_WAIT(); asm volatile("" ::: "memory");
}
__device__ __forceinline__ void tr_job(int r, const float* W, int K, int N, bf16_t* WT, int ldt, int kc0, int kind, int off, LAS float* scr, int lane) {
    const int nblk = N / 32, kb = r / nblk, nb = r % nblk;
    tr_item(W, N, 64 * kb, 32 * nb, WT, ldt, kc0, kind, off, scr, lane);
}

__device__ __forceinline__ void p_conv(Frame& F) {
    int tid = threadIdx.x; asm volatile("" : "+v"(tid)); const int lane = tid & 63, wave = __builtin_amdgcn_readfirstlane(tid >> 6); (void)lane; (void)wave;

    unsigned char* ws = F.ws;
    LAS float* scr = (LAS float*)(F.lds + wave * 16384);
    const int gw = F.c * NWAVES + wave, NGW = F.G * NWAVES;
    constexpr int I_IN = 16 * 208, I_BR = 8 * 32, I_O = 16 * 32, I_GU = 16 * 88, I_D = 44 * 32;
    constexpr int NIT = 2 * I_IN + 4 * I_BR + 2 * I_O + 2 * I_GU + I_D;
    for (int it = gw; it < NIT; it += NGW) {
        int r = it;
        if (r < 2 * I_IN) { const int l = r / I_IN; r -= l * I_IN; tr_job(r, inp<I_WIN>() + (size_t)l * DM * INW, DM, INW, (bf16_t*)(ws + (l ? WS_WIN1 : WS_WIN0)), DM, 0, 1, 0, scr, lane); continue; } r -= 2 * I_IN;
        if (r < 4 * I_BR) { const int l = r / (2 * I_BR), j = (r / I_BR) & 1; r %= I_BR; tr_job(r, inp<I_WBR>() + (size_t)(l * 3 + j) * 512 * DM, 512, DM, (bf16_t*)(ws + (l ? WS_WM1 : WS_WM0)), 1536, 512 * j, 0, 0, scr, lane); continue; } r -= 4 * I_BR;
        if (r < 2 * I_O) { const int l = r / I_O; r -= l * I_O; tr_job(r, inp<I_WOUT>() + (size_t)l * DM * DM, DM, DM, (bf16_t*)(ws + (l ? WS_WO1 : WS_WO0)), DM, 0, 0, 0, scr, lane); continue; } r -= 2 * I_O;
        if (r < 2 * I_GU) { const int up = r / I_GU; r -= up * I_GU; tr_job(r, (up ? inp<I_FU>() : inp<I_FG>()), DM, DFF, (bf16_t*)(ws + WS_WGU), DM, 0, 2, up * 128, scr, lane); continue; } r -= 2 * I_GU;
        tr_job(r, inp<I_FD>(), DFF, DM, (bf16_t*)(ws + WS_WD), DFF, 0, 0, 0, scr, lane);
    }
    for (int it = F.c * NTHREADS + tid; it < 2 * 512 * 1024; it += F.G * NTHREADS) {
        const int n = it & 1023, gk = (it >> 10) & 511, l = it >> 19, g = gk >> 7;
        const float* pw = inp<I_POOLW>() + ((size_t)l * 512 + gk) * 128;
        const float* ps = inp<I_POOLS>() + l * 512 + g * 128;
        const float* wb = inp<I_WBR>() + ((size_t)(l * 3 + 2) * 512 + g * 128) * DM + n;
        float s = 0.f;
        for (int c = 0; c < 128; ++c) s += pw[c] * ps[c] * wb[(size_t)c * DM];
        ((bf16_t*)(ws + (l ? WS_WM1 : WS_WM0)))[(size_t)n * 1536 + 1024 + gk] = (bf16_t)(cvt_pk_bf16(s, 0.f) & 0xffffu);
    }
    __syncthreads();
    {
        LAS float* sl = (LAS float*)F.lds;
        LAS float* part = (LAS float*)(F.lds + 40960);
        for (int i = tid; i < 9 * 1024; i += NTHREADS) { const float v = (i < 8192) ? inp<I_C>()[i] : inp<I_CCTX>()[i - 8192]; sl[i] = silu_f(v); }
        __syncthreads();
        for (int item = F.c; item < 192; item += F.G) {
            const int l = item / 96, j0 = (item % 96) * 64;
            const float* wm = inp<I_WMOD>() + (size_t)l * DM * 6144 + j0 + lane;
            float a[9];
#pragma unroll
            for (int r = 0; r < 9; ++r) a[r] = 0.f;
            const int kb = wave * 128;
#pragma unroll 8
            for (int k = 0; k < 128; ++k) { const float w = wm[(size_t)(kb + k) * 6144];
#pragma unroll
                for (int r = 0; r < 9; ++r) a[r] += sl[r * 1024 + kb + k] * w; }
#pragma unroll
            for (int r = 0; r < 9; ++r) part[(wave * 9 + r) * 64 + lane] = a[r];
            __syncthreads();
            for (int i = tid; i < 576; i += NTHREADS) { const int r = i >> 6, ln = i & 63; float s = inp<I_BMOD>()[l * 6144 + j0 + ln];
#pragma unroll
                for (int w = 0; w < 8; ++w) s += part[(w * 9 + r) * 64 + ln];
                ((float*)(ws + WS_MOD))[(size_t)(l * 9 + r) * 6144 + j0 + ln] = s; }
            __syncthreads();
        }
    }
    if (F.c == 0) {
        float* rc = (float*)(ws + WS_ROPE); float* rs = rc + 1024;
        for (int i = tid; i < 1024; i += NTHREADS) { const int pos = i >> 4, f = i & 15; const float inv = powf(10000.0f, -(float)f / 16.0f); const float ang = (float)pos * inv; rc[i] = cosf(ang); rs[i] = sinf(ang); }
        if (wave == 0) {
            for (int l = 0; l < 2; ++l) {
                const float a = wave_sum(inp<I_LQ1>()[l * 64 + lane] * inp<I_LK1>()[l * 64 + lane]);
                const float b = wave_sum(inp<I_LQ2>()[l * 64 + lane] * inp<I_LK2>()[l * 64 + lane]);
                const float lam_init = l ? 0.35550907f : 0.2f;
                if (lane == 0) ((float*)(ws + WS_LAM))[l] = expf(a) - expf(b) + lam_init;
            }
        }
    }
}
__device__ __forceinline__ void p_conv_moe(Frame& F) {
    int tid = threadIdx.x; asm volatile("" : "+v"(tid)); const int lane = tid & 63, wave = __builtin_amdgcn_readfirstlane(tid >> 6); (void)lane; (void)wave;

    LAS float* scr = (LAS float*)(F.lds + wave * 16384);
    const int gw = F.c * NWAVES + wave, NGW = F.G * NWAVES;
    constexpr int I_GU = 16 * 88, I_D = 44 * 32, PER_E = 2 * I_GU + I_D;
    for (int it = gw; it < NE * PER_E; it += NGW) {
        const int e = it / PER_E; int r = it % PER_E;
        bf16_t* we = (bf16_t*)(F.ws + WS_WMOE + (size_t)e * MOE_ESTRIDE);
        if (r < 2 * I_GU) { const int up = r / I_GU; r -= up * I_GU; tr_job(r, (up ? inp<I_MU>() : inp<I_MG>()) + (size_t)e * DM * DFF, DM, DFF, we, DM, 0, 2, up * 128, scr, lane); }
        else { r -= 2 * I_GU; tr_job(r, inp<I_MD>() + (size_t)e * DFF * DM, DFF, DM, (bf16_t*)((unsigned char*)we + MOE_WD_OFF), DFF, 0, 0, 0, scr, lane); }
    }
}

__device__ __forceinline__ void ld_row_f32(const float* p, int lane, f32x4 (&v)[4]) {
#pragma unroll
    for (int j = 0; j < 4; ++j) v[j] = *(const f32x4*)(p + 4 * lane + 256 * j);
}
__device__ __forceinline__ void ld_row_bf16(const bf16_t* p, int lane, f32x4 (&v)[4]) {
#pragma unroll
    for (int j = 0; j < 4; ++j) { const u32x2 w = *(const u32x2*)(p + 4 * lane + 256 * j); v[j] = (f32x4){bf_lo(w.x), bf_hi(w.x), bf_lo(w.y), bf_hi(w.y)}; }
}
__device__ __forceinline__ void st_row_bf16(bf16_t* p, int lane, const f32x4 (&v)[4]) {
#pragma unroll
    for (int j = 0; j < 4; ++j) { u32x2 w; w.x = cvt_pk_bf16(v[j][0], v[j][1]); w.y = cvt_pk_bf16(v[j][2], v[j][3]); *(u32x2*)(p + 4 * lane + 256 * j) = w; }
}
__device__ __forceinline__ void st_row_f32(float* p, int lane, const f32x4 (&v)[4]) {
#pragma unroll
    for (int j = 0; j < 4; ++j) *(f32x4*)(p + 4 * lane + 256 * j) = v[j];
}
__device__ __forceinline__ float row_ss(const f32x4 (&v)[4]) {
    float s = 0.f;
#pragma unroll
    for (int j = 0; j < 4; ++j) s += (v[j][0] * v[j][0] + v[j][1] * v[j][1]) + (v[j][2] * v[j][2] + v[j][3] * v[j][3]);
    return wave_sum(s);
}
__device__ __forceinline__ void norm_mod_store(const f32x4 (&x)[4], const float* g, const float* sh, const float* sc, bf16_t* dst, int lane, f32x4 (&h)[4]) {
    const float rstd = 1.0f / sqrtf(row_ss(x) * (1.0f / DM) + EPS);
    f32x4 gv[4], sv[4], cv[4]; ld_row_f32(g, lane, gv); ld_row_f32(sh, lane, sv); ld_row_f32(sc, lane, cv);
#pragma unroll
    for (int j = 0; j < 4; ++j) h[j] = (x[j] * rstd * gv[j]) * (1.0f + cv[j]) + sv[j];
    st_row_bf16(dst, lane, h);
}
__device__ __forceinline__ void p_h0(Frame& F) {
    int tid = threadIdx.x; asm volatile("" : "+v"(tid)); const int lane = tid & 63, wave = __builtin_amdgcn_readfirstlane(tid >> 6); (void)lane; (void)wave;

    const int gw = F.c * NWAVES + wave, NGW = F.G * NWAVES;
    bf16_t* H = (bf16_t*)(F.ws + WS_H);
    for (int row = gw; row < MT; row += NGW) {
        const bool lat = row < ML; const int mr = lat ? (row >> 12) : 8;
        const float* xin = lat ? inp<I_X>() + (size_t)row * DM : inp<I_CTX>() + (size_t)(row - ML) * DM;
        const float* mod = (const float*)(F.ws + WS_MOD) + (size_t)mr * 6144;
        f32x4 x[4], h[4]; ld_row_f32(xin, lane, x);
        norm_mod_store(x, inp<I_GPREMIX>(), mod, mod + 1024, H + (size_t)row * DM, lane, h);
    }
}
__device__ __forceinline__ void p_nr1(Frame& F, const int l) {
    int tid = threadIdx.x; asm volatile("" : "+v"(tid)); const int lane = tid & 63, wave = __builtin_amdgcn_readfirstlane(tid >> 6); (void)lane; (void)wave;

    const bf16_t* MIX = (const bf16_t*)(F.ws + WS_MIX);
    bf16_t* H = (bf16_t*)(F.ws + (l ? WS_H : WS_H2_0));
    float* Y = (float*)(F.ws + WS_Y);
    LAS float* rwt = (LAS float*)F.lds;
    volatile LAS int* cntl = (volatile LAS int*)(F.MISC + 16);
    if (l == 1) { for (int i = tid; i < 8192; i += NTHREADS) rwt[(i & 7) * 1024 + (i >> 3)] = inp<I_RW>()[i]; }
    const int nrows = l ? ML : MT, nch = nrows / 128;
    for (int ch = F.c; ch < nch; ch += F.G) {
        if (l == 1) { if (tid < 8) cntl[tid] = 0; }
        __syncthreads();
        for (int i = 0; i < 16; ++i) {
            const int row = ch * 128 + wave * 16 + i;
            const bool lat = row < ML; const int mr = lat ? (row >> 12) : 8;
            const float* mod = (const float*)(F.ws + WS_MOD) + (size_t)(l * 9 + mr) * 6144;
            const float* xin = lat ? (l ? F.out : inp<I_X>()) + (size_t)row * DM : inp<I_CTX>() + (size_t)(row - ML) * DM;
            float* xo = lat ? F.out + (size_t)row * DM : Y + (size_t)(row - ML) * DM;
            f32x4 mx[4], x[4], g[4], gt[4], h[4];
            ld_row_bf16(MIX + (size_t)row * DM, lane, mx); ld_row_f32(xin, lane, x);
            ld_row_f32(inp<I_GPOSTMIX>() + l * DM, lane, g); ld_row_f32(mod + 2048, lane, gt);
            const float rstd = 1.0f / sqrtf(row_ss(mx) * (1.0f / DM) + EPS);
#pragma unroll
            for (int j = 0; j < 4; ++j) x[j] = x[j] + gt[j] * (mx[j] * rstd * g[j]);
            st_row_f32(xo, lane, x);
            norm_mod_store(x, inp<I_GPREFFN>() + l * DM, mod + 3072, mod + 4096, H + (size_t)row * DM, lane, h);
            if (l == 1) {
                float lg[8];
#pragma unroll
                for (int e = 0; e < 8; ++e) { float s = 0.f;
#pragma unroll
                    for (int j = 0; j < 4; ++j) { const f32x4 w = *(const LAS f32x4*)(rwt + e * 1024 + 4 * lane + 256 * j); s += (h[j][0] * w[0] + h[j][1] * w[1]) + (h[j][2] * w[2] + h[j][3] * w[3]); }
                    lg[e] = wave_sum(s); }
                int e0 = 0; float v0 = lg[0];
#pragma unroll
                for (int e = 1; e < 8; ++e) if (lg[e] > v0) { v0 = lg[e]; e0 = e; }
                int e1 = -1; float v1 = -3.0e38f;
#pragma unroll
                for (int e = 0; e < 8; ++e) if (e != e0 && lg[e] > v1) { v1 = lg[e]; e1 = e; }
                const float ex = expf(v1 - v0), p0 = 1.0f / (1.0f + ex), p1 = ex * p0;
                if (lane == 0) { ((int*)(F.ws + WS_TKE))[row * 2] = e0; ((int*)(F.ws + WS_TKE))[row * 2 + 1] = e1;
                    ((float*)(F.ws + WS_TKP))[row * 2] = p0; ((float*)(F.ws + WS_TKP))[row * 2 + 1] = p1;
                    __hip_atomic_fetch_add((LAS int*)&cntl[e0], 1, __ATOMIC_RELAXED, __HIP_MEMORY_SCOPE_WORKGROUP); __hip_atomic_fetch_add((LAS int*)&cntl[e1], 1, __ATOMIC_RELAXED, __HIP_MEMORY_SCOPE_WORKGROUP); }
            }
        }
        __syncthreads();
        if (l == 1 && tid < 8) ((int*)(F.ws + WS_CNT))[ch * 8 + tid] = cntl[tid];
        __syncthreads();
    }
}
__device__ __forceinline__ void p_nr2(Frame& F, const int l) {
    int tid = threadIdx.x; asm volatile("" : "+v"(tid)); const int lane = tid & 63, wave = __builtin_amdgcn_readfirstlane(tid >> 6); (void)lane; (void)wave;

    const int gw = F.c * NWAVES + wave, NGW = F.G * NWAVES;
    float* Y = (float*)(F.ws + WS_Y);
    const int nrows = l ? ML : MT;
    for (int row = gw; row < nrows; row += NGW) {
        const bool lat = row < ML; const int mr = lat ? (row >> 12) : 8;
        const float* mod = (const float*)(F.ws + WS_MOD) + (size_t)(l * 9 + mr) * 6144;
        float* xp = lat ? F.out + (size_t)row * DM : Y + (size_t)(row - ML) * DM;
        f32x4 f[4], x[4], g[4], gt[4];
        if (l == 0) ld_row_bf16((const bf16_t*)(F.ws + WS_F_0) + (size_t)row * DM, lane, f);
        else {
            const int s0 = ((const int*)(F.ws + WS_PSLOT))[row * 2], s1 = ((const int*)(F.ws + WS_PSLOT))[row * 2 + 1];
            const float p0 = ((const float*)(F.ws + WS_TKP))[row * 2], p1 = ((const float*)(F.ws + WS_TKP))[row * 2 + 1];
            f32x4 a[4], b[4]; ld_row_bf16((const bf16_t*)(F.ws + WS_OUTP) + (size_t)s0 * DM, lane, a); ld_row_bf16((const bf16_t*)(F.ws + WS_OUTP) + (size_t)s1 * DM, lane, b);
#pragma unroll
            for (int j = 0; j < 4; ++j) f[j] = p0 * a[j] + p1 * b[j];
        }
        ld_row_f32(xp, lane, x); ld_row_f32(inp<I_GPOSTFFN>() + l * DM, lane, g); ld_row_f32(mod + 5120, lane, gt);
        const float rstd = 1.0f / sqrtf(row_ss(f) * (1.0f / DM) + EPS);
#pragma unroll
        for (int j = 0; j < 4; ++j) x[j] = x[j] + gt[j] * (f[j] * rstd * g[j]);
        st_row_f32(xp, lane, x);
        if (l == 0) { const float* mod1 = (const float*)(F.ws + WS_MOD) + (size_t)(9 + mr) * 6144; f32x4 h[4];
            norm_mod_store(x, inp<I_GPREMIX>() + DM, mod1, mod1 + 1024, (bf16_t*)(F.ws + WS_H) + (size_t)row * DM, lane, h); }
    }
}
__device__ __forceinline__ void p_convpool(Frame& F, const int l) {
    int tid = threadIdx.x; asm volatile("" : "+v"(tid)); const int lane = tid & 63, wave = __builtin_amdgcn_readfirstlane(tid >> 6); (void)lane; (void)wave;

    const int gw = F.c * NWAVES + wave, NGW = F.G * NWAVES;
    bf16_t* CB = (bf16_t*)(F.ws + WS_CB); const bf16_t* U = (const bf16_t*)(F.ws + WS_U); const bf16_t* PIN = (const bf16_t*)(F.ws + WS_PIN); bf16_t* P = (bf16_t*)(F.ws + WS_P);
    const int nrows = l ? ML : MT; const int c0 = 8 * lane;
    const float* cw = inp<I_CONVW>() + l * 1536 + c0;
    const f32x4 w0a = *(const f32x4*)(cw), w0b = *(const f32x4*)(cw + 4), w1a = *(const f32x4*)(cw + 512), w1b = *(const f32x4*)(cw + 516), w2a = *(const f32x4*)(cw + 1024), w2b = *(const f32x4*)(cw + 1028);
    const int g = lane >> 4, hw = 1 << g;
    for (int row = gw; row < nrows; row += NGW) {
        const bool lat = row < ML; const int t = lat ? (row & 4095) : ((row - ML) & 255), L = lat ? SEQ : CTXL;
        const u32x4 z4 = {0u, 0u, 0u, 0u};
        const u32x4 uc = *(const u32x4*)(U + (size_t)row * 512 + c0);
        const u32x4 up = t > 0 ? *(const u32x4*)(U + (size_t)(row - 1) * 512 + c0) : z4;
        const u32x4 un = t < L - 1 ? *(const u32x4*)(U + (size_t)(row + 1) * 512 + c0) : z4;
        const u32x4 cb = *(const u32x4*)(CB + (size_t)row * 512 + c0);
        f32x4 o0, o1;
#define CV(w, lo_) ((lo_) ? bf_lo(w) : bf_hi(w))
        o0[0] = bf_lo(cb.x) * (w0a[0] * bf_lo(up.x) + w1a[0] * bf_lo(uc.x) + w2a[0] * bf_lo(un.x)); o0[1] = bf_hi(cb.x) * (w0a[1] * bf_hi(up.x) + w1a[1] * bf_hi(uc.x) + w2a[1] * bf_hi(un.x));
        o0[2] = bf_lo(cb.y) * (w0a[2] * bf_lo(up.y) + w1a[2] * bf_lo(uc.y) + w2a[2] * bf_lo(un.y)); o0[3] = bf_hi(cb.y) * (w0a[3] * bf_hi(up.y) + w1a[3] * bf_hi(uc.y) + w2a[3] * bf_hi(un.y));
        o1[0] = bf_lo(cb.z) * (w0b[0] * bf_lo(up.z) + w1b[0] * bf_lo(uc.z) + w2b[0] * bf_lo(un.z)); o1[1] = bf_hi(cb.z) * (w0b[1] * bf_hi(up.z) + w1b[1] * bf_hi(uc.z) + w2b[1] * bf_hi(un.z));
        o1[2] = bf_lo(cb.w) * (w0b[2] * bf_lo(up.w) + w1b[2] * bf_lo(uc.w) + w2b[2] * bf_lo(un.w)); o1[3] = bf_hi(cb.w) * (w0b[3] * bf_hi(up.w) + w1b[3] * bf_hi(uc.w) + w2b[3] * bf_hi(un.w));
#undef CV
        *(u32x4*)(CB + (size_t)row * 512 + c0) = pg8::pack8(o0, o1);
        const int lo = (t - hw) > 0 ? (t - hw) : 0, hi = (t + hw) < L ? (t + hw) : L;
        f32x4 s0 = {0.f, 0.f, 0.f, 0.f}, s1 = {0.f, 0.f, 0.f, 0.f};
        const bf16_t* pb = PIN + (size_t)(row - t) * 512 + c0;
        for (int tt = lo; tt < hi; ++tt) { const u32x4 w = *(const u32x4*)(pb + (size_t)tt * 512);
            s0 += (f32x4){bf_lo(w.x), bf_hi(w.x), bf_lo(w.y), bf_hi(w.y)}; s1 += (f32x4){bf_lo(w.z), bf_hi(w.z), bf_lo(w.w), bf_hi(w.w)}; }
        const float inv = 1.0f / (float)(hi - lo);
        const u32x4 w = *(const u32x4*)(pb + (size_t)t * 512);
        s0 = s0 * inv - (f32x4){bf_lo(w.x), bf_hi(w.x), bf_lo(w.y), bf_hi(w.y)}; s1 = s1 * inv - (f32x4){bf_lo(w.z), bf_hi(w.z), bf_lo(w.w), bf_hi(w.w)};
        *(u32x4*)(P + (size_t)row * 512 + c0) = pg8::pack8(s0, s1);
    }
}
__device__ __forceinline__ void p_attn(Frame& F, const int l, char* lds) {
    int tid = threadIdx.x; asm volatile("" : "+v"(tid)); const int lane = tid & 63, wave = __builtin_amdgcn_readfirstlane(tid >> 6); (void)lane; (void)wave;

    const bf16_t* Q = (const bf16_t*)(F.ws + WS_Q); const bf16_t* Kb = (const bf16_t*)(F.ws + WS_K); const bf16_t* Vb = (const bf16_t*)(F.ws + WS_V); bf16_t* AO = (bf16_t*)(F.ws + WS_AO);
    const float lam = ((const float*)(F.ws + WS_LAM))[l];
    const float lam_init = l ? 0.35550907f : 0.2f;
    LAS float* gsl = (LAS float*)(F.lds + 98304);
    if (tid < 128) gsl[tid] = inp<I_GSUB>()[l * 128 + tid] * (1.0f - lam_init);
    __syncthreads();
    const float* gs = (const float*)(lds + 98304);
    for (int uid = F.c; uid < 1024; uid += F.G) {
        const int xcd = uid & 7, j = uid >> 3, qb = j & 31, bh = (j >> 5) * 8 + xcd, b = bh >> 2, h = bh & 3;
        const size_t qrow = (size_t)b * SEQ + qb * 128, krow = (size_t)b * TALL;
        att::attn_unit(Q + qrow * 512 + h * 128, Kb + krow * 512 + h * 128, Vb + krow * 512 + h * 128, AO + qrow * 512 + h * 128, TALL, lam, gs, lds);
    }
    if (l == 0) {
        for (int uid = F.c; uid < 64; uid += F.G) {
            const int b = uid >> 3, h = (uid >> 1) & 3, qb = uid & 1;
            const size_t qrow = (size_t)ML + b * CTXL + qb * 128, krow = (size_t)b * TALL;
            att::attn_unit(Q + qrow * 512 + h * 128, Kb + krow * 512 + h * 128, Vb + krow * 512 + h * 128, AO + qrow * 512 + h * 128, CTXL, lam, gs, lds);
        }
    }
}
__device__ __forceinline__ void p_route(Frame& F) {
    int tid = threadIdx.x; asm volatile("" : "+v"(tid)); const int lane = tid & 63, wave = __builtin_amdgcn_readfirstlane(tid >> 6); (void)lane; (void)wave;

    volatile LAS int* sm = (volatile LAS int*)F.lds;
    const int* CNT = (const int*)(F.ws + WS_CNT); const int* TKE = (const int*)(F.ws + WS_TKE);
    int* ROWMAP = (int*)(F.ws + WS_ROWMAP); int* PSLOT = (int*)(F.ws + WS_PSLOT); int* PEXP = (int*)(F.ws + WS_PEXP);
    for (int ch = F.c; ch < 256; ch += F.G) {
        if (tid < 64) sm[tid] = 0;
        __syncthreads();
        { const int e = tid & 7, part = tid >> 3; int lt = 0, lp = 0;
#pragma unroll
          for (int q = 0; q < 4; ++q) { const int cq = part * 4 + q; const int v = CNT[cq * 8 + e]; lt += v; if (cq < ch) lp += v; }
          __hip_atomic_fetch_add((LAS int*)&sm[e], lt, __ATOMIC_RELAXED, __HIP_MEMORY_SCOPE_WORKGROUP); __hip_atomic_fetch_add((LAS int*)&sm[8 + e], lp, __ATOMIC_RELAXED, __HIP_MEMORY_SCOPE_WORKGROUP); }
        __syncthreads();
        if (tid == 0) { int b = 0; for (int e = 0; e < 8; ++e) { sm[16 + e] = b; b += (sm[e] + 255) & ~255; } sm[24] = b; }
        __syncthreads();
        int e = 0, rk = 0, tok = 0, k = 0;
        if (tid < 256) {
            const int tl = tid >> 1; k = tid & 1; tok = ch * 128 + tl; e = TKE[tok * 2 + k];
            const unsigned long long lt_mask = (1ull << lane) - 1ull;
#pragma unroll
            for (int ee = 0; ee < 8; ++ee) { const unsigned long long m = __ballot(e == ee); if (e == ee) rk = __popcll(m & lt_mask); if (lane == 0) sm[32 + wave * 8 + ee] = __popcll(m); }
        }
        __syncthreads();
        if (tid < 256) {
            int r = sm[16 + e] + sm[8 + e] + rk;
            for (int w = 0; w < wave; ++w) r += sm[32 + w * 8 + e];
            ROWMAP[r] = tok; PSLOT[tok * 2 + k] = r;
        }
        if (ch < 8) { const int st = sm[16 + ch] + sm[ch], en = sm[16 + ch + 1]; for (int s = st + tid; s < en; s += NTHREADS) ROWMAP[s] = 0; }
        if (ch == 8) { for (int p = tid; p < 272; p += NTHREADS) { int ee = 0;
#pragma unroll
                for (int q = 1; q < 8; ++q) if (p * 256 >= sm[16 + q]) ee = q;
                PEXP[p] = ee; }
            if (tid == 0) PEXP[272] = sm[24] >> 8; }
        __syncthreads();
    }
}

constexpr int NPH = 23;
__global__ void __launch_bounds__(NTHREADS, 2) mk_fwd(Args args) {
    extern __shared__ __attribute__((aligned(16))) unsigned char lds[];
    Frame F;
    F.lds = (LAS unsigned char*)lds; F.MISC = (volatile LAS unsigned*)(F.lds + MISC_OFF);
    const int tid0 = threadIdx.x;
    F.G = gridDim.x; F.c = blockIdx.x;
    F.out = args.out; F.ws = args.ws;
    unsigned char* ws = args.ws;
    for (int u = tid0; u < (LDS_BYTES - RING_BYTES) / 4; u += NTHREADS) ((LAS unsigned*)(F.lds + RING_BYTES))[u] = 0u;
    __syncthreads();
    const int lo = args.ph_lo, hi = args.ph_hi;
    XcdBarrier bar; bar.bar = (unsigned*)(ws + WS_CTL) + CW_BAR; bar.x = 0; bar.st = nullptr;
    if (hi - lo > 1) bar = xcd_barrier_post((unsigned*)(ws + WS_CTL) + CW_BAR, F.MISC + 8);
    int ph = 0;
#ifndef MK_SITES
#define MK_SITES 0xffffu
#endif
#define PH_BEGIN(site) if (((MK_SITES >> (site)) & 1u) && ph >= lo && ph < hi) {
#define PH_END   if (ph + 1 < hi) xcd_barrier(bar); } ++ph;

    PH_BEGIN(0) p_conv(F); PH_END
    PH_BEGIN(1) p_h0(F); PH_END

    for (int l = 0; l < 2; ++l) {
        PH_BEGIN(2)
            pg8::SchedG S; S.o.init(l ? 128 : 136, 26, F.G, F.c); S.A = (const char*)(ws + WS_H); S.B = (const char*)(ws + (l ? WS_WIN1 : WS_WIN0));
            S.astep = 256 * DM * 2; S.bstep = 256 * DM * 2; S.nx = l ? 32 : 0;
            pg8::EpiZ E{ws};
            pg8::gemm_phase<pg8::EpiZ, pg8::SchedG, false, false>(F.lds, DM, DM, DM, S, E, 0, 0, nullptr);
        PH_END
        PH_BEGIN(3)
            p_convpool(F, l);
            p_attn(F, l, (char*)lds);
        PH_END
        PH_BEGIN(4)
            pg8::SchedG S; S.o.init(l ? 128 : 136, 4, F.G, F.c); S.A = (const char*)(ws + WS_AO); S.B = (const char*)(ws + (l ? WS_WM1 : WS_WM0));
            S.astep = 256 * 512 * 2; S.bstep = 256 * 1536 * 2; S.nx = 0;
            pg8::EpiMerge E{(bf16_t*)(ws + WS_MERGED), (const bf16_t*)(ws + WS_GT)};
            pg8::gemm_phase<pg8::EpiMerge, pg8::SchedG, true, false>(F.lds, 1536, 512, 1536, S, E, (long)WS_CB - (long)WS_AO, (long)WS_P - (long)WS_AO, nullptr);
        PH_END
        PH_BEGIN(5)
            pg8::SchedG S; S.o.init(l ? 128 : 136, 4, F.G, F.c); S.A = (const char*)(ws + WS_MERGED); S.B = (const char*)(ws + (l ? WS_WO1 : WS_WO0));
            S.astep = 256 * DM * 2; S.bstep = 256 * DM * 2; S.nx = 0;
            pg8::EpiPlain E{(bf16_t*)(ws + WS_MIX), DM};
            pg8::gemm_phase<pg8::EpiPlain, pg8::SchedG, false, false>(F.lds, DM, DM, DM, S, E, 0, 0, nullptr);
            if (l == 1) { __syncthreads(); p_conv_moe(F); }
        PH_END
        PH_BEGIN(6) p_nr1(F, l); PH_END
        if (l == 0) {
            PH_BEGIN(7)
                pg8::SchedG S; S.o.init(136, 22, F.G, F.c); S.A = (const char*)(ws + WS_H2_0); S.B = (const char*)(ws + WS_WGU);
                S.astep = 256 * DM * 2; S.bstep = 256 * DM * 2; S.nx = 0;
                pg8::EpiGlu E{(bf16_t*)(ws + WS_ACT0)};
                pg8::gemm_phase<pg8::EpiGlu, pg8::SchedG, false, false>(F.lds, DM, DM, DM, S, E, 0, 0, nullptr);
            PH_END
            PH_BEGIN(8)
                pg8::SchedG S; S.o.init(136, 4, F.G, F.c); S.A = (const char*)(ws + WS_ACT0); S.B = (const char*)(ws + WS_WD);
                S.astep = 256 * DFF * 2; S.bstep = 256 * DFF * 2; S.nx = 0;
                pg8::EpiPlain E{(bf16_t*)(ws + WS_F_0), DM};
                pg8::gemm_phase<pg8::EpiPlain, pg8::SchedG, false, false>(F.lds, DFF, DFF, DFF, S, E, 0, 0, nullptr);
            PH_END
        } else {
            PH_BEGIN(9) p_route(F); PH_END
            for (int ci = 0; ci < 3; ++ci) {
                PH_BEGIN(10)
                    const int np_all = __builtin_amdgcn_readfirstlane(((const int*)(ws + WS_PEXP))[272]);
                    int np = np_all - 128 * ci; np = np < 0 ? 0 : (np > 128 ? 128 : np);
                    if (np > 0) {
                        pg8::SchedMoe S; S.o.init(np, 22, F.G, F.c); S.p0 = 128 * ci; S.pexp = (const int*)(ws + WS_PEXP); S.A = (const char*)(ws + WS_H); S.astep = 0;
                        S.B = (const char*)(ws + WS_WMOE); S.estride = (int)MOE_ESTRIDE; S.bstep = 256 * DM * 2;
                        pg8::EpiGlu E{(bf16_t*)(ws + WS_ACT1)};
                        pg8::gemm_phase<pg8::EpiGlu, pg8::SchedMoe, false, true>(F.lds, DM, DM, DM, S, E, 0, 0, (const int*)(ws + WS_ROWMAP));
                    }
                PH_END
                PH_BEGIN(11)
                    const int np_all = __builtin_amdgcn_readfirstlane(((const int*)(ws + WS_PEXP))[272]);
                    int np = np_all - 128 * ci; np = np < 0 ? 0 : (np > 128 ? 128 : np);
                    if (np > 0) {
                        pg8::SchedMoe S; S.o.init(np, 4, F.G, F.c); S.p0 = 128 * ci; S.pexp = (const int*)(ws + WS_PEXP); S.A = (const char*)(ws + WS_ACT1); S.astep = 256 * DFF * 2;
                        S.B = (const char*)(ws + WS_WMOE + MOE_WD_OFF); S.estride = (int)MOE_ESTRIDE; S.bstep = 256 * DFF * 2;
                        pg8::EpiPlain E{(bf16_t*)(ws + WS_OUTP) + (size_t)ci * 32768 * DM, DM};
                        pg8::gemm_phase<pg8::EpiPlain, pg8::SchedMoe, false, false>(F.lds, DFF, DFF, DFF, S, E, 0, 0, nullptr);
                    }
                PH_END
            }
        }
        PH_BEGIN(12) p_nr2(F, l); PH_END
    }
#undef PH_BEGIN
#undef PH_END
}

extern "C" void kernel_launch(void* const* d_in, const int* in_sizes, int n_in, void* d_out, int out_size, void* d_ws, size_t ws_size, hipStream_t stream) {
    static int grid = 0;
    if (grid == 0) {
        if (n_in != 28 || in_sizes[0] != ML * DM || out_size != ML * DM || ws_size < WS_END) {
            fprintf(stderr, "kernel_launch: shape/workspace mismatch (n_in %d, ws %zu, need %zu); nothing launched\n", n_in, ws_size, (size_t)WS_END); grid = -1; return; }
        if (hipFuncSetAttribute((const void*)mk_fwd, hipFuncAttributeMaxDynamicSharedMemorySize, LDS_BYTES) != hipSuccess) { fprintf(stderr, "kernel_launch: hipFuncSetAttribute failed\n"); grid = -1; return; }
        int dev = 0, cus = 0, per_cu = 0;
        if (hipGetDevice(&dev) != hipSuccess || hipDeviceGetAttribute(&cus, hipDeviceAttributeMultiprocessorCount, dev) != hipSuccess) { grid = -1; return; }
        if (hipOccupancyMaxActiveBlocksPerMultiprocessor(&per_cu, (const void*)mk_fwd, NTHREADS, LDS_BYTES) != hipSuccess || per_cu < 1)
            fprintf(stderr, "kernel_launch: occupancy query reports %d\n", per_cu);
        (void)hipGetLastError();
        grid = cus;
        if (grid != 256) fprintf(stderr, "kernel_launch: %d CUs (built for 256)\n", grid);
    }
    if (grid < 0) return;
    if (hipMemsetAsync((char*)d_ws + WS_CTL, 0, CTL_ZERO_BYTES, stream) != hipSuccess) return;
    Args a{};
    for (int i = 0; i < 28; ++i) a.in[i] = (const float*)d_in[i];
    a.out = (float*)d_out; a.ws = (unsigned char*)d_ws;
#if MK_MULTI
    for (int p = 0; p < NPH; ++p) { a.ph_lo = p; a.ph_hi = p + 1; hipLaunchKernelGGL(mk_fwd, dim3(grid), dim3(NTHREADS), LDS_BYTES, stream, a); }
#else
    a.ph_lo = 0; a.ph_hi = NPH;
    hipLaunchKernelGGL(mk_fwd, dim3(grid), dim3(NTHREADS), LDS_BYTES, stream, a);
#endif
    const hipError_t le = hipPeekAtLastError();
    if (le != hipSuccess) fprintf(stderr, "kernel_launch: launch failed: %s\n", hipGetErrorName(le));
}
```

```cpp
#include <hip/hip_runtime.h>
#include <cstdio>
#include <cstdint>

#ifndef MK_MULTI
#define MK_MULTI 0
#endif

#define LAS __attribute__((address_space(3)))
#define GAS __attribute__((address_space(1)))
typedef unsigned short bf16_t;
typedef short bf16x8 __attribute__((ext_vector_type(8)));
typedef short s16x4 __attribute__((ext_vector_type(4)));
typedef float f32x2 __attribute__((ext_vector_type(2)));
typedef float f32x4 __attribute__((ext_vector_type(4)));
typedef float f32x16 __attribute__((ext_vector_type(16)));
typedef unsigned u32x2 __attribute__((ext_vector_type(2)));
typedef unsigned u32x4 __attribute__((ext_vector_type(4)));

constexpr int NB = 8, SEQ = 4096, DM = 1024, CTXL = 256;
constexpr int ML = NB * SEQ, MC = NB * CTXL, MT = ML + MC, TALL = SEQ + CTXL;
constexpr int INW = 6656, DFF = 2816, NE = 8;
constexpr float EPS = 1e-6f;
constexpr int NWAVES = 8, NTHREADS = 512;

constexpr size_t MiB = 1u << 20, HMiB = 1u << 19;
constexpr size_t WS_CTL = 0, CTL_ZERO_BYTES = 64 * 1024;
constexpr size_t WS_MOD = 1 * MiB;
constexpr size_t WS_ROPE = 1 * MiB + 512 * 1024;
constexpr size_t WS_LAM = WS_ROPE + 16384;
constexpr size_t WS_TKE = 2 * MiB;
constexpr size_t WS_TKP = 2 * MiB + 256 * 1024;
constexpr size_t WS_PSLOT = 2 * MiB + 512 * 1024;
constexpr size_t WS_ROWMAP = 2 * MiB + 768 * 1024;
constexpr size_t WS_CNT = 3 * MiB + 256 * 1024;
constexpr size_t WS_PEXP = 3 * MiB + 320 * 1024;
constexpr size_t WS_Y = 4 * MiB;
constexpr size_t WS_WIN1 = 12 * MiB, WS_WM1 = 25 * MiB, WS_WO1 = 28 * MiB;
constexpr size_t WS_WIN0 = 30 * MiB, WS_WM0 = 43 * MiB, WS_WO0 = 46 * MiB, WS_WGU = 48 * MiB, WS_WD = 59 * MiB;
constexpr size_t WS_Q = 64 * MiB + HMiB, WS_K = WS_Q + 34 * MiB, WS_V = WS_K + 34 * MiB;
constexpr size_t WS_CB = WS_V + 34 * MiB, WS_U = WS_CB + 34 * MiB, WS_PIN = WS_U + 34 * MiB;
constexpr size_t WS_GT = WS_PIN + 34 * MiB;
constexpr size_t WS_H = WS_GT + 204 * MiB;
constexpr size_t WS_AO = WS_H, WS_P = WS_H + 34 * MiB;
constexpr size_t WS_END = WS_H + 68 * MiB;
constexpr size_t WS_MERGED = WS_Q;
constexpr size_t WS_MIX = WS_U;
constexpr size_t WS_H2_0 = WS_GT;
constexpr size_t WS_F_0 = WS_GT + 68 * MiB;
constexpr size_t WS_ACT0 = WS_Q;
constexpr size_t WS_WMOE = WS_GT + 72 * MiB;
constexpr size_t MOE_ESTRIDE = 16 * MiB + HMiB, MOE_WD_OFF = 11 * MiB;
constexpr size_t WS_ACT1 = 30 * MiB;
constexpr size_t WS_OUTP = 206 * MiB;
static_assert(WS_OUTP + 132 * MiB <= WS_WMOE && WS_ACT1 + 176 * MiB <= WS_OUTP && WS_WMOE + 132 * MiB <= WS_H, "moe map");
static_assert(WS_ACT0 + (size_t)MT * DFF * 2 <= WS_H2_0, "dense act map");

constexpr int CW_TMO = 0;
constexpr int CW_BAR = 1024;

constexpr int RING_BYTES = 131072;
constexpr int MISC_OFF = RING_BYTES + 320;
constexpr int LDS_BYTES = 147456;

#define LDS_WAIT() asm volatile("s_waitcnt lgkmcnt(0)" ::: "memory")
#define VM_WAIT() asm volatile("s_waitcnt vmcnt(0)" ::: "memory")
__device__ __forceinline__ unsigned cvt_pk_bf16(float lo, float hi) { unsigned r; asm volatile("v_cvt_pk_bf16_f32 %0, %1, %2" : "=v"(r) : "v"(lo), "v"(hi)); return r; }
__device__ __forceinline__ float bf_lo(unsigned u) { return __uint_as_float(u << 16); }
__device__ __forceinline__ float bf_hi(unsigned u) { return __uint_as_float(u & 0xffff0000u); }
__device__ __forceinline__ float wave_sum(float v) {
#pragma unroll
    for (int o = 1; o < 64; o <<= 1) v += __shfl_xor(v, o);
    return v;
}
__device__ __forceinline__ float fast_rcp(float x) { return __builtin_amdgcn_rcpf(x); }
__device__ __forceinline__ float sigmoid_c(float x) { x = fminf(fmaxf(x, -30.f), 30.f); return fast_rcp(1.f + __builtin_amdgcn_exp2f(-1.4426950408889634f * x)); }
__device__ __forceinline__ float silu_f(float x) { return x * fast_rcp(1.f + __builtin_amdgcn_exp2f(-1.4426950408889634f * x)); }

#define XB_TMO      128
#define XB_XCNT(j)  (256  + 64 * (j))
#define XB_XSUB(j)  (1280 + 64 * (j))
#define XB_XGEN(j)  (2304 + 64 * (j))
#define XB_TOP      3328
#define XB_TOPGEN   3392
#define XCD_BAR_WORDS 3456
#define XB_SPIN_CAP (1u << 20)
__device__ __forceinline__ unsigned xb_ld(unsigned* p)              { return __hip_atomic_load(p, __ATOMIC_RELAXED, __HIP_MEMORY_SCOPE_AGENT); }
__device__ __forceinline__ unsigned xb_add(unsigned* p, unsigned v) { return __hip_atomic_fetch_add(p, v, __ATOMIC_RELAXED, __HIP_MEMORY_SCOPE_AGENT); }
__device__ __forceinline__ unsigned xb_xcc_id() { return (unsigned)__builtin_amdgcn_s_getreg((3 << 11) | 20) & 0xFu; }
#define XB_SPIN(cond, bar) do { unsigned _sp = 0; while (cond) { __builtin_amdgcn_s_sleep(1); \
    if ((++_sp & 255u) == 0u) { if (xb_ld(&(bar)[XB_TMO])) break; if (_sp > XB_SPIN_CAP) { atomicAdd(&(bar)[XB_TMO], 1u); break; } } } } while (0)
struct XcdBarrier { unsigned* bar; unsigned x; volatile LAS unsigned* st; };
__device__ __forceinline__ XcdBarrier xcd_barrier_post(unsigned* bar, volatile LAS unsigned* st) {
    XcdBarrier b; b.bar = bar; b.x = xb_xcc_id(); b.st = st;
    if (threadIdx.x == 0) (void)xb_add(&bar[XB_XCNT(b.x)], 1u);
    return b;
}
__device__ __forceinline__ void xcd_barrier_complete(unsigned* bar, unsigned x, unsigned& nloc, unsigned& nx) {
    const unsigned G = gridDim.x * gridDim.y * gridDim.z;
    unsigned sum, cnt, mine, sp = 0u;
    for (;;) {
        sum = 0u; cnt = 0u; mine = 0u;
#pragma unroll
        for (unsigned j = 0; j < 16; ++j) { const unsigned c = xb_ld(&bar[XB_XCNT(j)]); sum += c; cnt += (c > 0u) ? 1u : 0u; mine = (j == x) ? c : mine; }
        if (sum == G) break;
        __builtin_amdgcn_s_sleep(1);
        if ((++sp & 255u) == 0u) { if (xb_ld(&bar[XB_TMO])) break; if (sp > XB_SPIN_CAP) { atomicAdd(&bar[XB_TMO], 1u); break; } }
    }
    nloc = mine > 0u ? mine : 1u; nx = cnt > 0u ? cnt : 1u;
}
__device__ __forceinline__ void xcd_barrier(const XcdBarrier& b) {
    asm volatile("s_waitcnt vmcnt(0)" ::: "memory");
    __syncthreads();
    if (threadIdx.x == 0) {
        unsigned* bar = b.bar;
        __builtin_amdgcn_s_waitcnt(0);
        unsigned nloc = b.st[0], nx = b.st[1];
        if (nloc == 0u) { xcd_barrier_complete(bar, b.x, nloc, nx); b.st[0] = nloc; b.st[1] = nx; }
        const unsigned old = xb_add(&bar[XB_XSUB(b.x)], 1u);
        const unsigned gen = old / nloc;
        if (old + 1u == (gen + 1u) * nloc) {
            __builtin_amdgcn_fence(__ATOMIC_RELEASE, "agent");
            asm volatile("s_waitcnt vmcnt(0)" ::: "memory");
            const unsigned og = xb_add(&bar[XB_TOP], 1u);
            const unsigned tg = og / nx;
            if (og + 1u == (tg + 1u) * nx) xb_add(&bar[XB_TOPGEN], 1u);
            else XB_SPIN(xb_ld(&bar[XB_TOPGEN]) == tg, bar);
            __builtin_amdgcn_fence(__ATOMIC_ACQUIRE, "agent");
            xb_add(&bar[XB_XGEN(b.x)], 1u);
            asm volatile("s_waitcnt vmcnt(0)" ::: "memory");
        } else {
            XB_SPIN(xb_ld(&bar[XB_XGEN(b.x)]) == gen, bar);
            __builtin_amdgcn_fence(__ATOMIC_ACQUIRE, "agent");
            asm volatile("s_waitcnt vmcnt(0)" ::: "memory");
        }
    }
    __syncthreads();
}

namespace pg8 {
constexpr int BM = 256, BK = 64, HALF = 128, HTB = HALF * BK * 2, STAGE_BYTES = 8 * HTB, NXCD = 8, WGM = 8;
__device__ __forceinline__ int lds_byte(int r, int c) { const int st = (r >> 4) * 2 + (c >> 5), rr = r & 15, cc = c & 31, ob = rr * 64 + cc * 2; return st * 1024 + (ob ^ (((ob >> 9) & 1) << 5)); }
__device__ __forceinline__ void stage_rc(int b, int& R, int& C) { const int st = b / 1024, sb = b % 1024, swz = sb ^ (((sb >> 9) & 1) << 5); R = (st >> 1) * 16 + swz / 64; C = (st & 1) * 32 + (swz % 64) / 2; }
__device__ __forceinline__ int perm32(int rho) { const int n = rho >> 4, i = rho & 15; return 8 * (i >> 2) + 4 * n + (i & 3); }

struct Unit { int pm, pn, aux; const char* A; const char* B; };

struct TileOrder {
    int nM, nN, nwg, G, c;
    __device__ __forceinline__ void init(int nM_, int nN_, int G_, int c_) { nM = nM_; nN = nN_; nwg = nM * nN; G = G_; c = c_; }
    __device__ __forceinline__ void tile(int L, int& pm, int& pn) const {
        int wgid = L; { const int q = nwg / NXCD, r = nwg % NXCD, xcd = wgid % NXCD, off = wgid / NXCD; wgid = (xcd < r ? xcd * (q + 1) : r * (q + 1) + (xcd - r) * q) + off; }
        const int nig = WGM * nN, gid = wgid / nig, fm = gid * WGM, gsz = (nM - fm) < WGM ? (nM - fm) : WGM;
        pm = fm + ((wgid % nig) % gsz); pn = (wgid % nig) / gsz;
    }
};

template <class Epi, class Sched, bool KSEG, bool GATHER>
__device__ __forceinline__ void gemm_phase(LAS unsigned char* lds, const int K, const int lda, const int ldb, const Sched& S, const Epi& E,
                                           const long segoff1, const long segoff2, const int* __restrict__ rowmap) {
    int tid = threadIdx.x; asm volatile("" : "+v"(tid));
    const int wid = __builtin_amdgcn_readfirstlane(tid >> 6), lane = tid & 63, wr = wid >> 2, wc = wid & 3, fr = lane & 15, fq = lane >> 4;
    const int nt = K / BK;
    int Rr[2], Cc[2];
    unsigned voffB[2], vaC[2][2], vaN[2][2];
    const size_t hstepB = (size_t)HALF * ldb * 2;
#pragma unroll
    for (int i = 0; i < 2; ++i) { stage_rc(tid * 16 + i * 8192, Rr[i], Cc[i]); const int Rb = (Rr[i] & ~31) + perm32(Rr[i] & 31);
        voffB[i] = (unsigned)(Rb * ldb + Cc[i]) * 2u;
#pragma unroll
        for (int h = 0; h < 2; ++h) { vaC[h][i] = (unsigned)((h * HALF + Rr[i]) * lda + Cc[i]) * 2u; vaN[h][i] = vaC[h][i]; } }
    const unsigned ldsw = (unsigned)wid * 1024u;
    const int aoff = lds_byte(wr * 64 + fr, fq * 8), boff = lds_byte(wc * 32 + fr, fq * 8);
#define PG8_SA(b, h) (((b) * 2 + (h)) * HTB)
#define PG8_SB(b, h) ((4 + (b) * 2 + (h)) * HTB)
#define PG8_STAGE(bufoff, gbase, voff) do { _Pragma("unroll") for (int _i = 0; _i < 2; ++_i) \
        __builtin_amdgcn_global_load_lds((const unsigned*)((const char*)(gbase) + (voff)[_i]), (LAS unsigned*)(lds + (bufoff) + ldsw + _i * 8192), 16, 0, 0); } while (0)
#define PG8_LDA(dst, b, h) do { _Pragma("unroll") for (int m = 0; m < 4; ++m) _Pragma("unroll") for (int k = 0; k < 2; ++k) dst[m][k] = *(const LAS bf16x8*)(lds + PG8_SA(b, h) + aoff + m * 2048 + k * 1024); } while (0)
#define PG8_LDB(dst, b, h) do { _Pragma("unroll") for (int n = 0; n < 2; ++n) _Pragma("unroll") for (int k = 0; k < 2; ++k) dst[n][k] = *(const LAS bf16x8*)(lds + PG8_SB(b, h) + boff + n * 2048 + k * 1024); } while (0)
#define PG8_MMA(ai, bj, At, Bt) do { __builtin_amdgcn_s_setprio(1); _Pragma("unroll") for (int m = 0; m < 4; ++m) _Pragma("unroll") for (int n = 0; n < 2; ++n) _Pragma("unroll") for (int k = 0; k < 2; ++k) \
        acc[ai][bj][m][n] = __builtin_amdgcn_mfma_f32_16x16x32_bf16(Bt[n][k], At[m][k], acc[ai][bj][m][n], 0, 0, 0); __builtin_amdgcn_s_setprio(0); } while (0)
#define PG8_WAIT_V(n) asm volatile("s_waitcnt vmcnt(" #n ")" ::: "memory")
#define PG8_WAIT_L(n) asm volatile("s_waitcnt lgkmcnt(" #n ")" ::: "memory")
#define PG8_BAR __builtin_amdgcn_s_barrier()
#define PG8_SCHED __builtin_amdgcn_sched_barrier(0)
#define PG8_KOFF(t) (KSEG ? ((long)(((t) >> 3) == 0 ? 0L : (((t) >> 3) == 1 ? segoff1 : segoff2)) + (long)((t) & 7) * 128L) : (long)(t) * 128L)
#define PG8_GATHER(dst, u) do { if constexpr (GATHER) { _Pragma("unroll") for (int _h = 0; _h < 2; ++_h) _Pragma("unroll") for (int _i = 0; _i < 2; ++_i) \
        dst[_h][_i] = (unsigned)(rowmap[(u).aux * 256 + _h * HALF + Rr[_i]] * lda + Cc[_i]) * 2u; } } while (0)
    Unit cur, nxt; int ui = 0;
    if (!S.next(0, cur)) return;
    f32x4 acc[2][2][4][2];
#pragma unroll
    for (int a = 0; a < 2; ++a)
#pragma unroll
        for (int b = 0; b < 2; ++b)
#pragma unroll
            for (int m = 0; m < 4; ++m)
#pragma unroll
                for (int n = 0; n < 2; ++n) acc[a][b][m][n] = (f32x4){0.f, 0.f, 0.f, 0.f};
    bf16x8 At[4][2], B0[2][2], B1[2][2];
    const char* cA = cur.A; const char* cB = cur.B;
    PG8_GATHER(vaC, cur);
    PG8_STAGE(PG8_SB(0, 0), cB, voffB); PG8_STAGE(PG8_SB(0, 1), cB + hstepB, voffB); PG8_STAGE(PG8_SA(0, 0), cA, vaC[0]); PG8_STAGE(PG8_SA(0, 1), cA, vaC[1]);
    if (wr == 1) PG8_BAR;
    PG8_WAIT_V(2); PG8_BAR;
    PG8_STAGE(PG8_SB(1, 0), cB + 128, voffB); PG8_STAGE(PG8_SA(1, 0), cA + PG8_KOFF(1), vaC[0]); PG8_STAGE(PG8_SB(1, 1), cB + hstepB + 128, voffB);
    PG8_WAIT_V(6); PG8_BAR;
    for (;;) {
        const bool has_next = S.next(ui + 1, nxt);
        const char* nA = has_next ? nxt.A : cA; const char* nB = has_next ? nxt.B : cB;
        if constexpr (GATHER) { if (has_next) { PG8_GATHER(vaN, nxt); } else {
#pragma unroll
            for (int h = 0; h < 2; ++h)
#pragma unroll
                for (int i = 0; i < 2; ++i) vaN[h][i] = vaC[h][i]; } }
        const int tchunk = Epi::MIDK ? 8 : nt;
        for (int t0 = 0; t0 < nt; t0 += tchunk) {
        if constexpr (Epi::MIDK) { if (t0 > 0) { PG8_SCHED; E.rescale(acc, cur, (t0 >> 3) - 1, wr, wc, fr, fq); PG8_SCHED; } }
        for (int t = t0; t < t0 + tchunk; t += 2) {
            const bool last = (t == nt - 2);
            const char* a1 = cA + PG8_KOFF(t + 1);
            const char* a2 = last ? nA : cA + PG8_KOFF(t + 2); const char* b2 = last ? nB : cB + (size_t)(t + 2) * 128;
            const char* a3 = last ? nA + PG8_KOFF(1) : cA + PG8_KOFF(t + 3); const char* b3 = b2 + 128;
            unsigned v20[2], v21[2];
#pragma unroll
            for (int i = 0; i < 2; ++i) { v20[i] = (GATHER && last) ? vaN[0][i] : vaC[0][i]; v21[i] = (GATHER && last) ? vaN[1][i] : vaC[1][i]; }
            PG8_LDB(B0, 0, 0); PG8_LDB(B1, 0, 1); PG8_SCHED; PG8_LDA(At, 0, 0); PG8_STAGE(PG8_SA(1, 1), a1, vaC[1]);
            PG8_WAIT_V(8); PG8_WAIT_L(0); PG8_BAR; PG8_MMA(0, 0, At, B0); PG8_MMA(0, 1, At, B1); PG8_BAR; PG8_SCHED;
            PG8_LDA(At, 0, 1); PG8_STAGE(PG8_SB(0, 0), b2, voffB); PG8_STAGE(PG8_SB(0, 1), b2 + hstepB, voffB); PG8_STAGE(PG8_SA(0, 0), a2, v20);
            PG8_WAIT_V(8); PG8_WAIT_L(0); PG8_BAR; PG8_MMA(1, 0, At, B0); PG8_MMA(1, 1, At, B1); PG8_BAR; PG8_SCHED;
            PG8_LDB(B0, 1, 0); PG8_LDB(B1, 1, 1); PG8_SCHED; PG8_LDA(At, 1, 0); PG8_STAGE(PG8_SA(0, 1), a2, v21);
            PG8_WAIT_V(8); PG8_WAIT_L(0); PG8_BAR; PG8_MMA(0, 0, At, B0); PG8_MMA(0, 1, At, B1); PG8_BAR; PG8_SCHED;
            PG8_LDA(At, 1, 1); PG8_STAGE(PG8_SB(1, 0), b3, voffB); PG8_STAGE(PG8_SB(1, 1), b3 + hstepB, voffB); PG8_STAGE(PG8_SA(1, 0), a3, v20);
            PG8_WAIT_V(8); PG8_WAIT_L(0); PG8_BAR; PG8_MMA(1, 0, At, B0); PG8_MMA(1, 1, At, B1); PG8_BAR; PG8_SCHED;
        }
        }
        if (wr == 0) PG8_BAR;
        E(acc, cur, wr, wc, fr, fq);
        if (!has_next) break;
#pragma unroll
        for (int a = 0; a < 2; ++a)
#pragma unroll
            for (int b = 0; b < 2; ++b)
#pragma unroll
                for (int m = 0; m < 4; ++m)
#pragma unroll
                    for (int n = 0; n < 2; ++n) acc[a][b][m][n] = (f32x4){0.f, 0.f, 0.f, 0.f};
        cur = nxt; cA = nA; cB = nB; ++ui;
        if constexpr (GATHER) {
#pragma unroll
            for (int h = 0; h < 2; ++h)
#pragma unroll
                for (int i = 0; i < 2; ++i) vaC[h][i] = vaN[h][i]; }
        if (wr == 1) PG8_BAR;
    }
    PG8_WAIT_V(0);
    PG8_BAR;
#undef PG8_SA
#undef PG8_SB
#undef PG8_STAGE
#undef PG8_LDA
#undef PG8_LDB
#undef PG8_MMA
#undef PG8_WAIT_V
#undef PG8_WAIT_L
#undef PG8_BAR
#undef PG8_SCHED
#undef PG8_KOFF
#undef PG8_GATHER
}

struct SchedG {
    TileOrder o; const char* A; const char* B; int astep, bstep; int nx;
    __device__ __forceinline__ bool next(int i, Unit& u) const {
        const long L = (long)i * o.G + o.c;
        if (L < o.nwg) { o.tile((int)L, u.pm, u.pn); }
        else { const int x = (int)(L - o.nwg); if (x >= nx) return false; u.pm = 128 + (x >> 2); u.pn = 2 + (x & 3); }
        u.aux = u.pm; u.A = A + (size_t)u.pm * astep; u.B = B + (size_t)u.pn * bstep; return true;
    }
};
struct SchedMoe {
    TileOrder o; int p0; const int* pexp; const char* A; int astep; const char* B; int estride, bstep;
    __device__ __forceinline__ bool next(int i, Unit& u) const {
        const long L = (long)i * o.G + o.c;
        if (L >= o.nwg) return false;
        o.tile((int)L, u.pm, u.pn);
        const int e = __builtin_amdgcn_readfirstlane(pexp[p0 + u.pm]);
        u.aux = p0 + u.pm; u.A = A + (size_t)u.pm * astep; u.B = B + (size_t)e * estride + (size_t)u.pn * bstep; return true;
    }
};

typedef f32x4 Acc[2][2][4][2];
__device__ __forceinline__ u32x4 pack8(const f32x4 v0, const f32x4 v1) { u32x4 w; w.x = cvt_pk_bf16(v0[0], v0[1]); w.y = cvt_pk_bf16(v0[2], v0[3]); w.z = cvt_pk_bf16(v1[0], v1[1]); w.w = cvt_pk_bf16(v1[2], v1[3]); return w; }

struct EpiZ {
    static constexpr bool MIDK = false;
    unsigned char* ws;
    __device__ __forceinline__ void rescale(Acc&, const Unit&, int, int, int, int, int) const {}
    __device__ __forceinline__ void operator()(const Acc& acc, const Unit& u, int wr, int wc, int fr, int fq) const {
        const int pm = u.pm, pn = u.pn; const bool isctx = pm >= 128;
        bf16_t* const Q = (bf16_t*)(ws + WS_Q); bf16_t* const Kb = (bf16_t*)(ws + WS_K); bf16_t* const Vb = (bf16_t*)(ws + WS_V); bf16_t* const CB = (bf16_t*)(ws + WS_CB);
        bf16_t* const U = (bf16_t*)(ws + WS_U); bf16_t* const PIN = (bf16_t*)(ws + WS_PIN); bf16_t* const GT = (bf16_t*)(ws + WS_GT);
        const float* const ropeC = (const float*)(ws + WS_ROPE); const float* const ropeS = ropeC + 1024;
        int mode, pitch = 512, colt; bf16_t* base; bool krow = false;
        if (pn < 2) { mode = isctx ? 0 : 1; base = Q; colt = 256 * pn; }
        else if (pn < 4) { mode = isctx ? 0 : 1; base = Kb; colt = 256 * (pn - 2); krow = true; }
        else if (pn < 6) { mode = 0; base = Vb; colt = 256 * (pn - 4); krow = true; }
        else if (pn < 8) { mode = 0; base = CB; colt = 256 * (pn - 6); }
        else if (pn < 12) { mode = 2; base = U; colt = 128 * (pn - 8); }
        else if (pn < 14) { mode = 0; base = PIN; colt = 256 * (pn - 12); }
        else { mode = 3; base = GT; pitch = 3072; colt = 256 * (pn - 14); }
        const long rowbase = krow ? (isctx ? (long)(pm - 128) * TALL : (long)(pm >> 4) * TALL + CTXL + (pm & 15) * 256) : (long)pm * 256;
        const int cl = wc * 32 + 8 * fq;
#pragma unroll
        for (int ai = 0; ai < 2; ++ai)
#pragma unroll
            for (int m = 0; m < 4; ++m) {
                const int rl = ai * 128 + wr * 64 + m * 16 + fr;
                bf16_t* rowp = base + (size_t)(rowbase + rl) * pitch + colt + cl;
                if (mode == 2) {
                    const f32x4 a0 = acc[ai][0][m][0] * acc[ai][1][m][0], a1 = acc[ai][0][m][1] * acc[ai][1][m][1];
                    *(u32x4*)rowp = pack8(a0, a1);
                } else if (mode == 1) {
                    const int pos = (wc & 1) ? (m * 16 + fr) : ((pm & 15) * 4 + 2 * ai + wr);
                    const f32x4 cs = *(const f32x4*)(ropeC + pos * 16 + 4 * fq), sn = *(const f32x4*)(ropeS + pos * 16 + 4 * fq);
#pragma unroll
                    for (int bj = 0; bj < 2; ++bj) { const f32x4 v0 = acc[ai][bj][m][0], v1 = acc[ai][bj][m][1];
                        *(u32x4*)(rowp + bj * 128) = pack8(v0 * cs - v1 * sn, v1 * cs + v0 * sn); }
                } else if (mode == 3) {
#pragma unroll
                    for (int bj = 0; bj < 2; ++bj) { f32x4 v0 = acc[ai][bj][m][0], v1 = acc[ai][bj][m][1];
#pragma unroll
                        for (int j = 0; j < 4; ++j) { v0[j] = sigmoid_c(v0[j]); v1[j] = sigmoid_c(v1[j]); }
                        *(u32x4*)(rowp + bj * 128) = pack8(v0, v1); }
                } else {
#pragma unroll
                    for (int bj = 0; bj < 2; ++bj) *(u32x4*)(rowp + bj * 128) = pack8(acc[ai][bj][m][0], acc[ai][bj][m][1]);
                }
                asm volatile("" ::: "memory");
            }
    }
};
struct EpiPlain {
    static constexpr bool MIDK = false;
    bf16_t* O; int ldc;
    __device__ __forceinline__ void rescale(Acc&, const Unit&, int, int, int, int, int) const {}
    __device__ __forceinline__ void operator()(const Acc& acc, const Unit& u, int wr, int wc, int fr, int fq) const {
        const int cl = u.pn * 256 + wc * 32 + 8 * fq;
#pragma unroll
        for (int ai = 0; ai < 2; ++ai)
#pragma unroll
            for (int m = 0; m < 4; ++m) { bf16_t* rowp = O + (size_t)(u.pm * 256 + ai * 128 + wr * 64 + m * 16 + fr) * ldc + cl;
#pragma unroll
                for (int bj = 0; bj < 2; ++bj) *(u32x4*)(rowp + bj * 128) = pack8(acc[ai][bj][m][0], acc[ai][bj][m][1]); }
    }
};
struct EpiGlu {
    static constexpr bool MIDK = false;
    bf16_t* O;
    __device__ __forceinline__ void rescale(Acc&, const Unit&, int, int, int, int, int) const {}
    __device__ __forceinline__ void operator()(const Acc& acc, const Unit& u, int wr, int wc, int fr, int fq) const {
        const int cl = u.pn * 128 + wc * 32 + 8 * fq;
#pragma unroll
        for (int ai = 0; ai < 2; ++ai)
#pragma unroll
            for (int m = 0; m < 4; ++m) { bf16_t* rowp = O + (size_t)(u.pm * 256 + ai * 128 + wr * 64 + m * 16 + fr) * DFF + cl;
                f32x4 g0 = acc[ai][0][m][0], g1 = acc[ai][0][m][1];
#pragma unroll
                for (int j = 0; j < 4; ++j) { g0[j] = silu_f(g0[j]); g1[j] = silu_f(g1[j]); }
                *(u32x4*)rowp = pack8(g0 * acc[ai][1][m][0], g1 * acc[ai][1][m][1]); }
    }
};
struct EpiMerge {
    static constexpr bool MIDK = true;
    bf16_t* O; const bf16_t* GT;
    __device__ __forceinline__ void rescale(Acc& acc, const Unit& u, int j, int wr, int wc, int fr, int fq) const {
        const int cl = u.pn * 256 + wc * 32 + 8 * fq;
#pragma unroll
        for (int ai = 0; ai < 2; ++ai)
#pragma unroll
            for (int m = 0; m < 4; ++m) { const bf16_t* gp = GT + (size_t)(u.pm * 256 + ai * 128 + wr * 64 + m * 16 + fr) * 3072 + j * 1024 + cl;
#pragma unroll
                for (int bj = 0; bj < 2; ++bj) { const u32x4 a = *(const u32x4*)(gp + bj * 128), b = *(const u32x4*)(gp + 1024 + bj * 128);
                    f32x4 r0, r1;
                    r0[0] = bf_lo(a.x) * fast_rcp(bf_lo(b.x)); r0[1] = bf_hi(a.x) * fast_rcp(bf_hi(b.x)); r0[2] = bf_lo(a.y) * fast_rcp(bf_lo(b.y)); r0[3] = bf_hi(a.y) * fast_rcp(bf_hi(b.y));
                    r1[0] = bf_lo(a.z) * fast_rcp(bf_lo(b.z)); r1[1] = bf_hi(a.z) * fast_rcp(bf_hi(b.z)); r1[2] = bf_lo(a.w) * fast_rcp(bf_lo(b.w)); r1[3] = bf_hi(a.w) * fast_rcp(bf_hi(b.w));
                    acc[ai][bj][m][0] *= r0; acc[ai][bj][m][1] *= r1; }
                asm volatile("" ::: "memory"); }
    }
    __device__ __forceinline__ void operator()(const Acc& acc, const Unit& u, int wr, int wc, int fr, int fq) const {
        const int cl = u.pn * 256 + wc * 32 + 8 * fq;
#pragma unroll
        for (int ai = 0; ai < 2; ++ai)
#pragma unroll
            for (int m = 0; m < 4; ++m) { const size_t row = (size_t)(u.pm * 256 + ai * 128 + wr * 64 + m * 16 + fr);
                const bf16_t* gp = GT + row * 3072 + 2048 + cl; bf16_t* rowp = O + row * 1024 + cl;
#pragma unroll
                for (int bj = 0; bj < 2; ++bj) { const u32x4 a = *(const u32x4*)(gp + bj * 128);
                    const f32x4 g0 = (f32x4){bf_lo(a.x), bf_hi(a.x), bf_lo(a.y), bf_hi(a.y)}, g1 = (f32x4){bf_lo(a.z), bf_hi(a.z), bf_lo(a.w), bf_hi(a.w)};
                    *(u32x4*)(rowp + bj * 128) = pack8(acc[ai][bj][m][0] * g0, acc[ai][bj][m][1] * g1); }
                asm volatile("" ::: "memory"); }
    }
};
}

namespace att {
constexpr int KVBLK = 64;
constexpr float SCALE = 0.125f, THR = 8.f;
constexpr int LDQ = 512;
constexpr size_t SHM_V = KVBLK * 128 * 2, SHM_K = KVBLK * 128 * 2;
#define KSWZ(row, colB) ((row) * 256 + ((colB) ^ (((row) & 7) << 4)))
#define SBAR() __builtin_amdgcn_sched_barrier(0)
__device__ __forceinline__ int crow(int r, int hi) { return (r & 3) + 8 * (r >> 2) + 4 * hi; }
__device__ __forceinline__ void partialSM(f32x16& p0, f32x16& p1, float& m_reg, float& mn, float& alpha) {
    constexpr float C = SCALE * 1.4426950408889634f;
    float pmax = p0[0];
#pragma unroll
    for (int r = 1; r < 16; ++r) pmax = fmaxf(pmax, p0[r]);
#pragma unroll
    for (int r = 0; r < 16; ++r) pmax = fmaxf(pmax, p1[r]);
    { auto rr = __builtin_amdgcn_permlane32_swap(__float_as_uint(pmax), __float_as_uint(pmax), false, false);
      pmax = fmaxf(__uint_as_float(rr[0]), __uint_as_float(rr[1])); }
    if (__builtin_expect(__all(pmax - m_reg <= THR / SCALE), 1)) { mn = m_reg; alpha = 1.f; }
    else { mn = fmaxf(m_reg, pmax); alpha = __builtin_amdgcn_exp2f((m_reg - mn) * C); m_reg = mn; }
    const float mnC = -mn * C;
#pragma unroll
    for (int r = 0; r < 16; ++r) p0[r] = fmaf(p0[r], C, mnC);
#pragma unroll
    for (int r = 0; r < 16; ++r) p1[r] = fmaf(p1[r], C, mnC);
#pragma unroll
    for (int r = 0; r < 16; ++r) p0[r] = __builtin_amdgcn_exp2f(p0[r]);
}
__device__ __forceinline__ void finishSM(f32x16& p0, f32x16& p1, float alpha, float& l_reg, bf16x8& pa0, bf16x8& pa1, bf16x8& pa2, bf16x8& pa3) {
#pragma unroll
    for (int r = 0; r < 16; ++r) p1[r] = __builtin_amdgcn_exp2f(p1[r]);
    float ps = 0;
#pragma unroll
    for (int r = 0; r < 16; ++r) ps += p0[r];
#pragma unroll
    for (int r = 0; r < 16; ++r) ps += p1[r];
    { auto rr = __builtin_amdgcn_permlane32_swap(__float_as_uint(ps), __float_as_uint(ps), false, false);
      ps = __uint_as_float(rr[0]) + __uint_as_float(rr[1]); }
    l_reg = l_reg * alpha + ps;
#define PK4(P, BASE, OUT) do { unsigned a0 = cvt_pk_bf16(P[BASE + 0], P[BASE + 1]), a1 = cvt_pk_bf16(P[BASE + 2], P[BASE + 3]);   \
    unsigned b0 = cvt_pk_bf16(P[BASE + 4], P[BASE + 5]), b1 = cvt_pk_bf16(P[BASE + 6], P[BASE + 7]);                              \
    auto r0 = __builtin_amdgcn_permlane32_swap(a0, b0, false, false); auto r1 = __builtin_amdgcn_permlane32_swap(a1, b1, false, false); \
    u32x4 w = {r0[0], r1[0], r0[1], r1[1]}; OUT = *reinterpret_cast<bf16x8*>(&w); } while (0)
    PK4(p0, 0, pa0); PK4(p0, 8, pa1); PK4(p1, 0, pa2); PK4(p1, 8, pa3);
#undef PK4
}
__device__ __forceinline__ void qkt(f32x16& p0, f32x16& p1, const char* Ks, const bf16x8* qr, int r32, int hi, int map) {
    p0 = f32x16{}; p1 = f32x16{};
#pragma unroll
    for (int d0 = 0; d0 < 4; ++d0) { const int cb = (map * 64 + d0 * 16 + hi * 8) * 2;
        const bf16x8 b0 = *reinterpret_cast<const bf16x8*>(Ks + KSWZ(r32, cb));
        const bf16x8 b1 = *reinterpret_cast<const bf16x8*>(Ks + KSWZ(32 + r32, cb));
        p0 = __builtin_amdgcn_mfma_f32_32x32x16_bf16(b0, qr[d0], p0, 0, 0, 0);
        p1 = __builtin_amdgcn_mfma_f32_32x32x16_bf16(b1, qr[d0], p1, 0, 0, 0); }
}
__device__ __forceinline__ int v_st(int k, int c) { const int kk = (k & ~0xC) | ((k & 4) << 1) | ((k & 8) >> 1); return ((kk >> 3) * 4 + (c >> 5)) * 512 + ((kk & 7) * 32 + (c & 31)) * 2; }
__device__ __forceinline__ int v_rd_base(int lane) { return ((lane & 3) << 3) | (((lane >> 2) & 3) << 6) | (((lane >> 4) & 1) << 5) | (((lane >> 5) & 1) << 8); }
constexpr int v_rd_off(int d0, int ks, int half) { return d0 * 512 + ks * 4096 + half * 2048; }
template <int OFF> __device__ __forceinline__ s16x4 tr_read(int vb) {
    s16x4 r; asm volatile("ds_read_b64_tr_b16 %0, %1 offset:%2" : "=&v"(r) : "v"(vb), "i"(OFF) : "memory"); return r;
}
template <int D0> __device__ __forceinline__ void pv_one(f32x16& od, int vb, bf16x8 pa0, bf16x8 pa1, bf16x8 pa2, bf16x8 pa3) {
    const s16x4 l0 = tr_read<v_rd_off(D0, 0, 0)>(vb), h0 = tr_read<v_rd_off(D0, 0, 1)>(vb), l1 = tr_read<v_rd_off(D0, 1, 0)>(vb), h1 = tr_read<v_rd_off(D0, 1, 1)>(vb);
    const s16x4 l2 = tr_read<v_rd_off(D0, 2, 0)>(vb), h2 = tr_read<v_rd_off(D0, 2, 1)>(vb), l3 = tr_read<v_rd_off(D0, 3, 0)>(vb), h3 = tr_read<v_rd_off(D0, 3, 1)>(vb);
    asm volatile("s_waitcnt lgkmcnt(0)" ::: "memory"); SBAR();
#define PK(L, H) (bf16x8){L[0], L[1], L[2], L[3], H[0], H[1], H[2], H[3]}
    od = __builtin_amdgcn_mfma_f32_32x32x16_bf16(pa0, PK(l0, h0), od, 0, 0, 0);
    od = __builtin_amdgcn_mfma_f32_32x32x16_bf16(pa1, PK(l1, h1), od, 0, 0, 0);
    od = __builtin_amdgcn_mfma_f32_32x32x16_bf16(pa2, PK(l2, h2), od, 0, 0, 0);
    od = __builtin_amdgcn_mfma_f32_32x32x16_bf16(pa3, PK(l3, h3), od, 0, 0, 0);
#undef PK
}
__device__ __forceinline__ void pv_d0(f32x16* o, int vb, bf16x8 pa0, bf16x8 pa1, bf16x8 pa2, bf16x8 pa3) {
    pv_one<0>(o[0], vb, pa0, pa1, pa2, pa3); pv_one<1>(o[1], vb, pa0, pa1, pa2, pa3); pv_one<2>(o[2], vb, pa0, pa1, pa2, pa3); pv_one<3>(o[3], vb, pa0, pa1, pa2, pa3);
}

__device__ __forceinline__ void attn_unit(const bf16_t* __restrict__ Qb, const bf16_t* __restrict__ Kh, const bf16_t* __restrict__ Vh, bf16_t* __restrict__ Ob,
                                          const int seq, const float lam, const float* __restrict__ gs, char* lds) {
    int tid = threadIdx.x; asm volatile("" : "+v"(tid));
    const int wid = tid >> 6, lane = tid & 63, r32 = lane & 31, hi = lane >> 5, map = wid >> 2, wq = wid & 3;
    char* V_lds = lds; char* K_lds = lds + 2 * SHM_V;
    float* ws = (float*)(lds + 2 * SHM_V + 2 * SHM_K) + wid * 64; float* li_l = ws; float* al_l = ws + 32;
    float m_reg = -1e30f, l_reg = 0; f32x16 o[4] = {}; bf16x8 qr[4];
    const bf16_t* Qw = Qb + (long)(wq * 32 + r32) * LDQ + map * 64 + hi * 8;
#pragma unroll
    for (int d0 = 0; d0 < 4; ++d0) qr[d0] = *reinterpret_cast<const bf16x8*>(Qw + d0 * 16);
    const int sr = tid >> 4, sc = (tid & 15) * 8, vst0 = v_st(sr, sc), vst1 = v_st(32 + sr, sc);
    const int vb0 = (int)(uintptr_t)V_lds + v_rd_base(lane);
    struct { bf16x8 vs0, vs1, ks0, ks1; } sr_[2];
#define SLOAD(i, k0) do { sr_[i].vs0 = *reinterpret_cast<const bf16x8*>(&Vh[(long)((k0) + sr) * 512 + sc]); sr_[i].vs1 = *reinterpret_cast<const bf16x8*>(&Vh[(long)((k0) + 32 + sr) * 512 + sc]); \
    sr_[i].ks0 = *reinterpret_cast<const bf16x8*>(&Kh[(long)((k0) + sr) * 512 + sc]); sr_[i].ks1 = *reinterpret_cast<const bf16x8*>(&Kh[(long)((k0) + 32 + sr) * 512 + sc]); } while (0)
#define SWRITE(b, i) do { *(bf16x8*)(V_lds + (b) * SHM_V + vst0) = sr_[i].vs0;          \
    *(bf16x8*)(V_lds + (b) * SHM_V + vst1) = sr_[i].vs1; const int kc = sc * 2;               \
    *(bf16x8*)(K_lds + (b) * SHM_K + KSWZ(sr, kc)) = sr_[i].ks0;                       \
    *(bf16x8*)(K_lds + (b) * SHM_K + KSWZ(32 + sr, kc)) = sr_[i].ks1; } while (0)
#define SWAIT() asm volatile("s_waitcnt vmcnt(4)" ::: "memory")
#define RESC(a) do { if (__any((a) < 1.f)) { if (hi == 0) al_l[r32] = (a); asm volatile("s_waitcnt lgkmcnt(0)" ::: "memory"); \
    _Pragma("unroll") for (int d = 0; d < 4; ++d) _Pragma("unroll") for (int r = 0; r < 16; ++r) o[d][r] *= al_l[crow(r, hi)]; } } while (0)
    f32x16 pA0, pA1, pB0, pB1; float mnA, mnB, alA, alB; bf16x8 pa0, pa1, pa2, pa3; const int NT = seq / KVBLK;
    constexpr int SE = 0, SO = 1;
    SLOAD(SE, 0); asm volatile("s_waitcnt vmcnt(0)" ::: "memory"); SWRITE(0, SE); __syncthreads();
    qkt(pA0, pA1, K_lds, qr, r32, hi, map); partialSM(pA0, pA1, m_reg, mnA, alA);
    SLOAD(SO, KVBLK); if (2 < NT) SLOAD(SE, 2 * KVBLK);
    SWAIT(); SWRITE(1, SO); __syncthreads();
    for (int j = 1; j + 1 < NT; j += 2) {
        SBAR(); qkt(pB0, pB1, K_lds + SHM_K, qr, r32, hi, map);
        finishSM(pA0, pA1, alA, l_reg, pa0, pa1, pa2, pa3); SBAR();
        SLOAD(SO, (j + 2) * KVBLK); SBAR();
        pv_d0(o, vb0, pa0, pa1, pa2, pa3); partialSM(pB0, pB1, m_reg, mnB, alB);
        __syncthreads(); SWAIT(); SWRITE(0, SE);
        RESC(alB); __syncthreads();
        SBAR(); qkt(pA0, pA1, K_lds, qr, r32, hi, map);
        finishSM(pB0, pB1, alB, l_reg, pa0, pa1, pa2, pa3); SBAR();
        if (j + 3 < NT) SLOAD(SE, (j + 3) * KVBLK); SBAR();
        pv_d0(o, vb0 + (int)SHM_V, pa0, pa1, pa2, pa3); partialSM(pA0, pA1, m_reg, mnA, alA);
        __syncthreads(); SWAIT(); SWRITE(1, SO);
        RESC(alA); __syncthreads();
    }
    SBAR(); qkt(pB0, pB1, K_lds + SHM_K, qr, r32, hi, map);
    finishSM(pA0, pA1, alA, l_reg, pa0, pa1, pa2, pa3); SBAR();
    pv_d0(o, vb0, pa0, pa1, pa2, pa3); partialSM(pB0, pB1, m_reg, mnB, alB);
    __syncthreads(); RESC(alB);
    finishSM(pB0, pB1, alB, l_reg, pa0, pa1, pa2, pa3); SBAR();
    pv_d0(o, vb0 + (int)SHM_V, pa0, pa1, pa2, pa3);
    if (hi == 0) li_l[r32] = l_reg; asm volatile("s_waitcnt lgkmcnt(0)" ::: "memory");
    float rli[16];
#pragma unroll
    for (int r = 0; r < 16; ++r) rli[r] = 1.0f / li_l[crow(r, hi)];
#pragma unroll
    for (int d0 = 0; d0 < 4; ++d0)
#pragma unroll
        for (int r = 0; r < 16; ++r) o[d0][r] *= rli[r];
    __syncthreads();
    float* X = (float*)lds + wq * (32 * 128);
    if (map == 1) {
#pragma unroll
        for (int d0 = 0; d0 < 4; ++d0)
#pragma unroll
            for (int r = 0; r < 16; ++r) X[crow(r, hi) * 128 + d0 * 32 + r32] = o[d0][r];
    }
    __syncthreads();
    if (map == 0) {
#pragma unroll
        for (int d0 = 0; d0 < 4; ++d0)
#pragma unroll
            for (int r = 0; r < 16; ++r) o[d0][r] -= lam * X[crow(r, hi) * 128 + d0 * 32 + r32];
        float g4[4];
#pragma unroll
        for (int d0 = 0; d0 < 4; ++d0) g4[d0] = gs[d0 * 32 + r32];
#pragma unroll
        for (int r = 0; r < 16; ++r) {
            float ss = o[0][r] * o[0][r] + o[1][r] * o[1][r] + o[2][r] * o[2][r] + o[3][r] * o[3][r];
            ss += __shfl_xor(ss, 1); ss += __shfl_xor(ss, 2); ss += __shfl_xor(ss, 4); ss += __shfl_xor(ss, 8); ss += __shfl_xor(ss, 16);
            const float rstd = 1.0f / sqrtf(ss * (1.0f / 128.0f) + EPS);
            bf16_t* op = Ob + (long)(wq * 32 + crow(r, hi)) * 512 + r32;
#pragma unroll
            for (int d0 = 0; d0 < 4; ++d0) op[d0 * 32] = (bf16_t)(cvt_pk_bf16(o[d0][r] * rstd * g4[d0], 0.f) & 0xffffu);
        }
    }
    __syncthreads();
#undef SLOAD
#undef SWRITE
#undef SWAIT
#undef RESC
}
#undef KSWZ
}

struct Args { const float* in[28]; float* out; unsigned char* ws; int ph_lo, ph_hi; };

struct Frame {
    LAS unsigned char* lds; volatile LAS unsigned* MISC;
    int c, G;
    float* out; unsigned char* ws;
};
template <int I> __device__ __forceinline__ const float* inp() {
    unsigned long long p;
    asm volatile("s_load_dwordx2 %0, %1, %2\n\ts_waitcnt lgkmcnt(0)" : "=s"(p) : "s"(__builtin_amdgcn_kernarg_segment_ptr()), "n"(I * 8));
    return (const float*)(const GAS float*)p;
}
enum { I_X = 0, I_C, I_CTX, I_CCTX, I_WMOD, I_BMOD, I_GPREMIX, I_GPOSTMIX, I_GPREFFN, I_GPOSTFFN, I_WIN, I_LQ1, I_LK1, I_LQ2, I_LK2, I_GSUB, I_CONVW, I_POOLW, I_POOLS,
       I_WBR, I_WOUT, I_FG, I_FU, I_FD, I_RW, I_MG, I_MU, I_MD };

__device__ __forceinline__ int rowmap_f(int kind, int off, int n) {
    if (kind == 0) return n + off;
    if (kind == 2) return ((n >> 7) << 8) + off + (n & 127);
    if (n < 1024) { const int ch = n >> 6, o = n & 63, a = o >> 5, hh = (o >> 4) & 1, f = o & 15; return ch * 64 + a * 32 + 8 * (f >> 2) + 4 * hh + (f & 3); }
    if (n >= 2048 && n < 3072) { const int x = n - 2048, isx = x >> 9, chn = x & 511; return 2048 + ((chn >> 7) << 8) + isx * 128 + (chn & 127); }
    return n;
}
__device__ __forceinline__ void tr_item(const float* __restrict__ W, int N, int k0, int n0, bf16_t* __restrict__ WT, int ldt, int kc0, int kind, int off, LAS float* scr, int lane) {
#pragma unroll 8
    for (int i = 0; i < 32; ++i) { const int kk = 2 * i + (lane >> 5); scr[kk * 33 + (lane & 31)] = W[(size_t)(k0 + kk) * N + n0 + (lane & 31)]; }
    LDS_WAIT(); asm volatile("" ::: "memory");
    const int c = lane & 7;
#pragma unroll
    for (int j = 0; j < 4; ++j) { const int n = (lane >> 3) + 8 * j; const LAS float* s = scr + (8 * c) * 33 + n;
        u32x4 o; o.x = cvt_pk_bf16(s[0 * 33], s[1 * 33]); o.y = cvt_pk_bf16(s[2 * 33], s[3 * 33]); o.z = cvt_pk_bf16(s[4 * 33], s[5 * 33]); o.w = cvt_pk_bf16(s[6 * 33], s[7 * 33]);
        *(u32x4*)(WT + (size_t)rowmap_f(kind, off, n0 + n) * ldt + kc0 + k0 + 8 * c) = o; }
    LDS_WAIT(); asm volatile("" ::: "memory");
}
__device__ __forceinline__ void tr_job(int r, const float* W, int K, int N, bf16_t* WT, int ldt, int kc0, int kind, int off, LAS float* scr, int lane) {
    const int nblk = N / 32, kb = r / nblk, nb = r % nblk;
    tr_item(W, N, 64 * kb, 32 * nb, WT, ldt, kc0, kind, off, scr, lane);
}

__device__ __forceinline__ void p_conv(Frame& F) {
    int tid = threadIdx.x; asm volatile("" : "+v"(tid)); const int lane = tid & 63, wave = __builtin_amdgcn_readfirstlane(tid >> 6); (void)lane; (void)wave;

    unsigned char* ws = F.ws;
    LAS float* scr = (LAS float*)(F.lds + wave * 16384);
    const int gw = F.c * NWAVES + wave, NGW = F.G * NWAVES;
    constexpr int I_IN = 16 * 208, I_BR = 8 * 32, I_O = 16 * 32, I_GU = 16 * 88, I_D = 44 * 32;
    constexpr int NIT = 2 * I_IN + 4 * I_BR + 2 * I_O + 2 * I_GU + I_D;
    for (int it = gw; it < NIT; it += NGW) {
        int r = it;
        if (r < 2 * I_IN) { const int l = r / I_IN; r -= l * I_IN; tr_job(r, inp<I_WIN>() + (size_t)l * DM * INW, DM, INW, (bf16_t*)(ws + (l ? WS_WIN1 : WS_WIN0)), DM, 0, 1, 0, scr, lane); continue; } r -= 2 * I_IN;
        if (r < 4 * I_BR) { const int l = r / (2 * I_BR), j = (r / I_BR) & 1; r %= I_BR; tr_job(r, inp<I_WBR>() + (size_t)(l * 3 + j) * 512 * DM, 512, DM, (bf16_t*)(ws + (l ? WS_WM1 : WS_WM0)), 1536, 512 * j, 0, 0, scr, lane); continue; } r -= 4 * I_BR;
        if (r < 2 * I_O) { const int l = r / I_O; r -= l * I_O; tr_job(r, inp<I_WOUT>() + (size_t)l * DM * DM, DM, DM, (bf16_t*)(ws + (l ? WS_WO1 : WS_WO0)), DM, 0, 0, 0, scr, lane); continue; } r -= 2 * I_O;
        if (r < 2 * I_GU) { const int up = r / I_GU; r -= up * I_GU; tr_job(r, (up ? inp<I_FU>() : inp<I_FG>()), DM, DFF, (bf16_t*)(ws + WS_WGU), DM, 0, 2, up * 128, scr, lane); continue; } r -= 2 * I_GU;
        tr_job(r, inp<I_FD>(), DFF, DM, (bf16_t*)(ws + WS_WD), DFF, 0, 0, 0, scr, lane);
    }
    for (int it = F.c * NTHREADS + tid; it < 2 * 512 * 1024; it += F.G * NTHREADS) {
        const int n = it & 1023, gk = (it >> 10) & 511, l = it >> 19, g = gk >> 7;
        const float* pw = inp<I_POOLW>() + ((size_t)l * 512 + gk) * 128;
        const float* ps = inp<I_POOLS>() + l * 512 + g * 128;
        const float* wb = inp<I_WBR>() + ((size_t)(l * 3 + 2) * 512 + g * 128) * DM + n;
        float s = 0.f;
        for (int c = 0; c < 128; ++c) s += pw[c] * ps[c] * wb[(size_t)c * DM];
        ((bf16_t*)(ws + (l ? WS_WM1 : WS_WM0)))[(size_t)n * 1536 + 1024 + gk] = (bf16_t)(cvt_pk_bf16(s, 0.f) & 0xffffu);
    }
    __syncthreads();
    {
        LAS float* sl = (LAS float*)F.lds;
        LAS float* part = (LAS float*)(F.lds + 40960);
        for (int i = tid; i < 9 * 1024; i += NTHREADS) { const float v = (i < 8192) ? inp<I_C>()[i] : inp<I_CCTX>()[i - 8192]; sl[i] = silu_f(v); }
        __syncthreads();
        for (int item = F.c; item < 192; item += F.G) {
            const int l = item / 96, j0 = (item % 96) * 64;
            const float* wm = inp<I_WMOD>() + (size_t)l * DM * 6144 + j0 + lane;
            float a[9];
#pragma unroll
            for (int r = 0; r < 9; ++r) a[r] = 0.f;
            const int kb = wave * 128;
#pragma unroll 8
            for (int k = 0; k < 128; ++k) { const float w = wm[(size_t)(kb + k) * 6144];
#pragma unroll
                for (int r = 0; r < 9; ++r) a[r] += sl[r * 1024 + kb + k] * w; }
#pragma unroll
            for (int r = 0; r < 9; ++r) part[(wave * 9 + r) * 64 + lane] = a[r];
            __syncthreads();
            for (int i = tid; i < 576; i += NTHREADS) { const int r = i >> 6, ln = i & 63; float s = inp<I_BMOD>()[l * 6144 + j0 + ln];
#pragma unroll
                for (int w = 0; w < 8; ++w) s += part[(w * 9 + r) * 64 + ln];
                ((float*)(ws + WS_MOD))[(size_t)(l * 9 + r) * 6144 + j0 + ln] = s; }
            __syncthreads();
        }
    }
    if (F.c == 0) {
        float* rc = (float*)(ws + WS_ROPE); float* rs = rc + 1024;
        for (int i = tid; i < 1024; i += NTHREADS) { const int pos = i >> 4, f = i & 15; const float inv = powf(10000.0f, -(float)f / 16.0f); const float ang = (float)pos * inv; rc[i] = cosf(ang); rs[i] = sinf(ang); }
        if (wave == 0) {
            for (int l = 0; l < 2; ++l) {
                const float a = wave_sum(inp<I_LQ1>()[l * 64 + lane] * inp<I_LK1>()[l * 64 + lane]);
                const float b = wave_sum(inp<I_LQ2>()[l * 64 + lane] * inp<I_LK2>()[l * 64 + lane]);
                const float lam_init = l ? 0.35550907f : 0.2f;
                if (lane == 0) ((float*)(ws + WS_LAM))[l] = expf(a) - expf(b) + lam_init;
            }
        }
    }
}
__device__ __forceinline__ void p_conv_moe(Frame& F) {
    int tid = threadIdx.x; asm volatile("" : "+v"(tid)); const int lane = tid & 63, wave = __builtin_amdgcn_readfirstlane(tid >> 6); (void)lane; (void)wave;

    LAS float* scr = (LAS float*)(F.lds + wave * 16384);
    const int gw = F.c * NWAVES + wave, NGW = F.G * NWAVES;
    constexpr int I_GU = 16 * 88, I_D = 44 * 32, PER_E = 2 * I_GU + I_D;
    for (int it = gw; it < NE * PER_E; it += NGW) {
        const int e = it / PER_E; int r = it % PER_E;
        bf16_t* we = (bf16_t*)(F.ws + WS_WMOE + (size_t)e * MOE_ESTRIDE);
        if (r < 2 * I_GU) { const int up = r / I_GU; r -= up * I_GU; tr_job(r, (up ? inp<I_MU>() : inp<I_MG>()) + (size_t)e * DM * DFF, DM, DFF, we, DM, 0, 2, up * 128, scr, lane); }
        else { r -= 2 * I_GU; tr_job(r, inp<I_MD>() + (size_t)e * DFF * DM, DFF, DM, (bf16_t*)((unsigned char*)we + MOE_WD_OFF), DFF, 0, 0, 0, scr, lane); }
    }
}

__device__ __forceinline__ void ld_row_f32(const float* p, int lane, f32x4 (&v)[4]) {
#pragma unroll
    for (int j = 0; j < 4; ++j) v[j] = *(const f32x4*)(p + 4 * lane + 256 * j);
}
__device__ __forceinline__ void ld_row_bf16(const bf16_t* p, int lane, f32x4 (&v)[4]) {
#pragma unroll
    for (int j = 0; j < 4; ++j) { const u32x2 w = *(const u32x2*)(p + 4 * lane + 256 * j); v[j] = (f32x4){bf_lo(w.x), bf_hi(w.x), bf_lo(w.y), bf_hi(w.y)}; }
}
__device__ __forceinline__ void st_row_bf16(bf16_t* p, int lane, const f32x4 (&v)[4]) {
#pragma unroll
    for (int j = 0; j < 4; ++j) { u32x2 w; w.x = cvt_pk_bf16(v[j][0], v[j][1]); w.y = cvt_pk_bf16(v[j][2], v[j][3]); *(u32x2*)(p + 4 * lane + 256 * j) = w; }
}
__device__ __forceinline__ void st_row_f32(float* p, int lane, const f32x4 (&v)[4]) {
#pragma unroll
    for (int j = 0; j < 4; ++j) *(f32x4*)(p + 4 * lane + 256 * j) = v[j];
}
__device__ __forceinline__ float row_ss(const f32x4 (&v)[4]) {
    float s = 0.f;
#pragma unroll
    for (int j = 0; j < 4; ++j) s += (v[j][0] * v[j][0] + v[j][1] * v[j][1]) + (v[j][2] * v[j][2] + v[j][3] * v[j][3]);
    return wave_sum(s);
}
__device__ __forceinline__ void norm_mod_store(const f32x4 (&x)[4], const float* g, const float* sh, const float* sc, bf16_t* dst, int lane, f32x4 (&h)[4]) {
    const float rstd = 1.0f / sqrtf(row_ss(x) * (1.0f / DM) + EPS);
    f32x4 gv[4], sv[4], cv[4]; ld_row_f32(g, lane, gv); ld_row_f32(sh, lane, sv); ld_row_f32(sc, lane, cv);
#pragma unroll
    for (int j = 0; j < 4; ++j) h[j] = (x[j] * rstd * gv[j]) * (1.0f + cv[j]) + sv[j];
    st_row_bf16(dst, lane, h);
}
__device__ __forceinline__ void p_h0(Frame& F) {
    int tid = threadIdx.x; asm volatile("" : "+v"(tid)); const int lane = tid & 63, wave = __builtin_amdgcn_readfirstlane(tid >> 6); (void)lane; (void)wave;

    const int gw = F.c * NWAVES + wave, NGW = F.G * NWAVES;
    bf16_t* H = (bf16_t*)(F.ws + WS_H);
    for (int row = gw; row < MT; row += NGW) {
        const bool lat = row < ML; const int mr = lat ? (row >> 12) : 8;
        const float* xin = lat ? inp<I_X>() + (size_t)row * DM : inp<I_CTX>() + (size_t)(row - ML) * DM;
        const float* mod = (const float*)(F.ws + WS_MOD) + (size_t)mr * 6144;
        f32x4 x[4], h[4]; ld_row_f32(xin, lane, x);
        norm_mod_store(x, inp<I_GPREMIX>(), mod, mod + 1024, H + (size_t)row * DM, lane, h);
    }
}
__device__ __forceinline__ void p_nr1(Frame& F, const int l) {
    int tid = threadIdx.x; asm volatile("" : "+v"(tid)); const int lane = tid & 63, wave = __builtin_amdgcn_readfirstlane(tid >> 6); (void)lane; (void)wave;

    const bf16_t* MIX = (const bf16_t*)(F.ws + WS_MIX);
    bf16_t* H = (bf16_t*)(F.ws + (l ? WS_H : WS_H2_0));
    float* Y = (float*)(F.ws + WS_Y);
    LAS float* rwt = (LAS float*)F.lds;
    volatile LAS int* cntl = (volatile LAS int*)(F.MISC + 16);
    if (l == 1) { for (int i = tid; i < 8192; i += NTHREADS) rwt[(i & 7) * 1024 + (i >> 3)] = inp<I_RW>()[i]; }
    const int nrows = l ? ML : MT, nch = nrows / 128;
    for (int ch = F.c; ch < nch; ch += F.G) {
        if (l == 1) { if (tid < 8) cntl[tid] = 0; }
        __syncthreads();
        for (int i = 0; i < 16; ++i) {
            const int row = ch * 128 + wave * 16 + i;
            const bool lat = row < ML; const int mr = lat ? (row >> 12) : 8;
            const float* mod = (const float*)(F.ws + WS_MOD) + (size_t)(l * 9 + mr) * 6144;
            const float* xin = lat ? (l ? F.out : inp<I_X>()) + (size_t)row * DM : inp<I_CTX>() + (size_t)(row - ML) * DM;
            float* xo = lat ? F.out + (size_t)row * DM : Y + (size_t)(row - ML) * DM;
            f32x4 mx[4], x[4], g[4], gt[4], h[4];
            ld_row_bf16(MIX + (size_t)row * DM, lane, mx); ld_row_f32(xin, lane, x);
            ld_row_f32(inp<I_GPOSTMIX>() + l * DM, lane, g); ld_row_f32(mod + 2048, lane, gt);
            const float rstd = 1.0f / sqrtf(row_ss(mx) * (1.0f / DM) + EPS);
#pragma unroll
            for (int j = 0; j < 4; ++j) x[j] = x[j] + gt[j] * (mx[j] * rstd * g[j]);
            st_row_f32(xo, lane, x);
            norm_mod_store(x, inp<I_GPREFFN>() + l * DM, mod + 3072, mod + 4096, H + (size_t)row * DM, lane, h);
            if (l == 1) {
                float lg[8];
#pragma unroll
                for (int e = 0; e < 8; ++e) { float s = 0.f;
#pragma unroll
                    for (int j = 0; j < 4; ++j) { const f32x4 w = *(const LAS f32x4*)(rwt + e * 1024 + 4 * lane + 256 * j); s += (h[j][0] * w[0] + h[j][1] * w[1]) + (h[j][2] * w[2] + h[j][3] * w[3]); }
                    lg[e] = wave_sum(s); }
                int e0 = 0; float v0 = lg[0];
#pragma unroll
                for (int e = 1; e < 8; ++e) if (lg[e] > v0) { v0 = lg[e]; e0 = e; }
                int e1 = -1; float v1 = -3.0e38f;
#pragma unroll
                for (int e = 0; e < 8; ++e) if (e != e0 && lg[e] > v1) { v1 = lg[e]; e1 = e; }
                const float ex = expf(v1 - v0), p0 = 1.0f / (1.0f + ex), p1 = ex * p0;
                if (lane == 0) { ((int*)(F.ws + WS_TKE))[row * 2] = e0; ((int*)(F.ws + WS_TKE))[row * 2 + 1] = e1;
                    ((float*)(F.ws + WS_TKP))[row * 2] = p0; ((float*)(F.ws + WS_TKP))[row * 2 + 1] = p1;
                    __hip_atomic_fetch_add((LAS int*)&cntl[e0], 1, __ATOMIC_RELAXED, __HIP_MEMORY_SCOPE_WORKGROUP); __hip_atomic_fetch_add((LAS int*)&cntl[e1], 1, __ATOMIC_RELAXED, __HIP_MEMORY_SCOPE_WORKGROUP); }
            }
        }
        __syncthreads();
        if (l == 1 && tid < 8) ((int*)(F.ws + WS_CNT))[ch * 8 + tid] = cntl[tid];
        __syncthreads();
    }
}
__device__ __forceinline__ void p_nr2(Frame& F, const int l) {
    int tid = threadIdx.x; asm volatile("" : "+v"(tid)); const int lane = tid & 63, wave = __builtin_amdgcn_readfirstlane(tid >> 6); (void)lane; (void)wave;

    const int gw = F.c * NWAVES + wave, NGW = F.G * NWAVES;
    float* Y = (float*)(F.ws + WS_Y);
    const int nrows = l ? ML : MT;
    for (int row = gw; row < nrows; row += NGW) {
        const bool lat = row < ML; const int mr = lat ? (row >> 12) : 8;
        const float* mod = (const float*)(F.ws + WS_MOD) + (size_t)(l * 9 + mr) * 6144;
        float* xp = lat ? F.out + (size_t)row * DM : Y + (size_t)(row - ML) * DM;
        f32x4 f[4], x[4], g[4], gt[4];
        if (l == 0) ld_row_bf16((const bf16_t*)(F.ws + WS_F_0) + (size_t)row * DM, lane, f);
        else {
            const int s0 = ((const int*)(F.ws + WS_PSLOT))[row * 2], s1 = ((const int*)(F.ws + WS_PSLOT))[row * 2 + 1];
            const float p0 = ((const float*)(F.ws + WS_TKP))[row * 2], p1 = ((const float*)(F.ws + WS_TKP))[row * 2 + 1];
            f32x4 a[4], b[4]; ld_row_bf16((const bf16_t*)(F.ws + WS_OUTP) + (size_t)s0 * DM, lane, a); ld_row_bf16((const bf16_t*)(F.ws + WS_OUTP) + (size_t)s1 * DM, lane, b);
#pragma unroll
            for (int j = 0; j < 4; ++j) f[j] = p0 * a[j] + p1 * b[j];
        }
        ld_row_f32(xp, lane, x); ld_row_f32(inp<I_GPOSTFFN>() + l * DM, lane, g); ld_row_f32(mod + 5120, lane, gt);
        const float rstd = 1.0f / sqrtf(row_ss(f) * (1.0f / DM) + EPS);
#pragma unroll
        for (int j = 0; j < 4; ++j) x[j] = x[j] + gt[j] * (f[j] * rstd * g[j]);
        st_row_f32(xp, lane, x);
        if (l == 0) { const float* mod1 = (const float*)(F.ws + WS_MOD) + (size_t)(9 + mr) * 6144; f32x4 h[4];
            norm_mod_store(x, inp<I_GPREMIX>() + DM, mod1, mod1 + 1024, (bf16_t*)(F.ws + WS_H) + (size_t)row * DM, lane, h); }
    }
}
__device__ __forceinline__ void p_convpool(Frame& F, const int l) {
    int tid = threadIdx.x; asm volatile("" : "+v"(tid)); const int lane = tid & 63, wave = __builtin_amdgcn_readfirstlane(tid >> 6); (void)lane; (void)wave;

    const int gw = F.c * NWAVES + wave, NGW = F.G * NWAVES;
    bf16_t* CB = (bf16_t*)(F.ws + WS_CB); const bf16_t* U = (const bf16_t*)(F.ws + WS_U); const bf16_t* PIN = (const bf16_t*)(F.ws + WS_PIN); bf16_t* P = (bf16_t*)(F.ws + WS_P);
    const int nrows = l ? ML : MT; const int c0 = 8 * lane;
    const float* cw = inp<I_CONVW>() + l * 1536 + c0;
    const f32x4 w0a = *(const f32x4*)(cw), w0b = *(const f32x4*)(cw + 4), w1a = *(const f32x4*)(cw + 512), w1b = *(const f32x4*)(cw + 516), w2a = *(const f32x4*)(cw + 1024), w2b = *(const f32x4*)(cw + 1028);
    const int g = lane >> 4, hw = 1 << g;
    for (int row = gw; row < nrows; row += NGW) {
        const bool lat = row < ML; const int t = lat ? (row & 4095) : ((row - ML) & 255), L = lat ? SEQ : CTXL;
        const u32x4 z4 = {0u, 0u, 0u, 0u};
        const u32x4 uc = *(const u32x4*)(U + (size_t)row * 512 + c0);
        const u32x4 up = t > 0 ? *(const u32x4*)(U + (size_t)(row - 1) * 512 + c0) : z4;
        const u32x4 un = t < L - 1 ? *(const u32x4*)(U + (size_t)(row + 1) * 512 + c0) : z4;
        const u32x4 cb = *(const u32x4*)(CB + (size_t)row * 512 + c0);
        f32x4 o0, o1;
#define CV(w, lo_) ((lo_) ? bf_lo(w) : bf_hi(w))
        o0[0] = bf_lo(cb.x) * (w0a[0] * bf_lo(up.x) + w1a[0] * bf_lo(uc.x) + w2a[0] * bf_lo(un.x)); o0[1] = bf_hi(cb.x) * (w0a[1] * bf_hi(up.x) + w1a[1] * bf_hi(uc.x) + w2a[1] * bf_hi(un.x));
        o0[2] = bf_lo(cb.y) * (w0a[2] * bf_lo(up.y) + w1a[2] * bf_lo(uc.y) + w2a[2] * bf_lo(un.y)); o0[3] = bf_hi(cb.y) * (w0a[3] * bf_hi(up.y) + w1a[3] * bf_hi(uc.y) + w2a[3] * bf_hi(un.y));
        o1[0] = bf_lo(cb.z) * (w0b[0] * bf_lo(up.z) + w1b[0] * bf_lo(uc.z) + w2b[0] * bf_lo(un.z)); o1[1] = bf_hi(cb.z) * (w0b[1] * bf_hi(up.z) + w1b[1] * bf_hi(uc.z) + w2b[1] * bf_hi(un.z));
        o1[2] = bf_lo(cb.w) * (w0b[2] * bf_lo(up.w) + w1b[2] * bf_lo(uc.w) + w2b[2] * bf_lo(un.w)); o1[3] = bf_hi(cb.w) * (w0b[3] * bf_hi(up.w) + w1b[3] * bf_hi(uc.w) + w2b[3] * bf_hi(un.w));
#undef CV
        *(u32x4*)(CB + (size_t)row * 512 + c0) = pg8::pack8(o0, o1);
        const int lo = (t - hw) > 0 ? (t - hw) : 0, hi = (t + hw) < L ? (t + hw) : L;
        f32x4 s0 = {0.f, 0.f, 0.f, 0.f}, s1 = {0.f, 0.f, 0.f, 0.f};
        const bf16_t* pb = PIN + (size_t)(row - t) * 512 + c0;
        for (int tt = lo; tt < hi; ++tt) { const u32x4 w = *(const u32x4*)(pb + (size_t)tt * 512);
            s0 += (f32x4){bf_lo(w.x), bf_hi(w.x), bf_lo(w.y), bf_hi(w.y)}; s1 += (f32x4){bf_lo(w.z), bf_hi(w.z), bf_lo(w.w), bf_hi(w.w)}; }
        const float inv = 1.0f / (float)(hi - lo);
        const u32x4 w = *(const u32x4*)(pb + (size_t)t * 512);
        s0 = s0 * inv - (f32x4){bf_lo(w.x), bf_hi(w.x), bf_lo(w.y), bf_hi(w.y)}; s1 = s1 * inv - (f32x4){bf_lo(w.z), bf_hi(w.z), bf_lo(w.w), bf_hi(w.w)};
        *(u32x4*)(P + (size_t)row * 512 + c0) = pg8::pack8(s0, s1);
    }
}
__device__ __forceinline__ void p_attn(Frame& F, const int l, char* lds) {
    int tid = threadIdx.x; asm volatile("" : "+v"(tid)); const int lane = tid & 63, wave = __builtin_amdgcn_readfirstlane(tid >> 6); (void)lane; (void)wave;

    const bf16_t* Q = (const bf16_t*)(F.ws + WS_Q); const bf16_t* Kb = (const bf16_t*)(F.ws + WS_K); const bf16_t* Vb = (const bf16_t*)(F.ws + WS_V); bf16_t* AO = (bf16_t*)(F.ws + WS_AO);
    const float lam = ((const float*)(F.ws + WS_LAM))[l];
    const float lam_init = l ? 0.35550907f : 0.2f;
    LAS float* gsl = (LAS float*)(F.lds + 98304);
    if (tid < 128) gsl[tid] = inp<I_GSUB>()[l * 128 + tid] * (1.0f - lam_init);
    __syncthreads();
    const float* gs = (const float*)(lds + 98304);
    for (int uid = F.c; uid < 1024; uid += F.G) {
        const int xcd = uid & 7, j = uid >> 3, qb = j & 31, bh = (j >> 5) * 8 + xcd, b = bh >> 2, h = bh & 3;
        const size_t qrow = (size_t)b * SEQ + qb * 128, krow = (size_t)b * TALL;
        att::attn_unit(Q + qrow * 512 + h * 128, Kb + krow * 512 + h * 128, Vb + krow * 512 + h * 128, AO + qrow * 512 + h * 128, TALL, lam, gs, lds);
    }
    if (l == 0) {
        for (int uid = F.c; uid < 64; uid += F.G) {
            const int b = uid >> 3, h = (uid >> 1) & 3, qb = uid & 1;
            const size_t qrow = (size_t)ML + b * CTXL + qb * 128, krow = (size_t)b * TALL;
            att::attn_unit(Q + qrow * 512 + h * 128, Kb + krow * 512 + h * 128, Vb + krow * 512 + h * 128, AO + qrow * 512 + h * 128, CTXL, lam, gs, lds);
        }
    }
}
__device__ __forceinline__ void p_route(Frame& F) {
    int tid = threadIdx.x; asm volatile("" : "+v"(tid)); const int lane = tid & 63, wave = __builtin_amdgcn_readfirstlane(tid >> 6); (void)lane; (void)wave;

    volatile LAS int* sm = (volatile LAS int*)F.lds;
    const int* CNT = (const int*)(F.ws + WS_CNT); const int* TKE = (const int*)(F.ws + WS_TKE);
    int* ROWMAP = (int*)(F.ws + WS_ROWMAP); int* PSLOT = (int*)(F.ws + WS_PSLOT); int* PEXP = (int*)(F.ws + WS_PEXP);
    for (int ch = F.c; ch < 256; ch += F.G) {
        if (tid < 64) sm[tid] = 0;
        __syncthreads();
        { const int e = tid & 7, part = tid >> 3; int lt = 0, lp = 0;
#pragma unroll
          for (int q = 0; q < 4; ++q) { const int cq = part * 4 + q; const int v = CNT[cq * 8 + e]; lt += v; if (cq < ch) lp += v; }
          __hip_atomic_fetch_add((LAS int*)&sm[e], lt, __ATOMIC_RELAXED, __HIP_MEMORY_SCOPE_WORKGROUP); __hip_atomic_fetch_add((LAS int*)&sm[8 + e], lp, __ATOMIC_RELAXED, __HIP_MEMORY_SCOPE_WORKGROUP); }
        __syncthreads();
        if (tid == 0) { int b = 0; for (int e = 0; e < 8; ++e) { sm[16 + e] = b; b += (sm[e] + 255) & ~255; } sm[24] = b; }
        __syncthreads();
        int e = 0, rk = 0, tok = 0, k = 0;
        if (tid < 256) {
            const int tl = tid >> 1; k = tid & 1; tok = ch * 128 + tl; e = TKE[tok * 2 + k];
            const unsigned long long lt_mask = (1ull << lane) - 1ull;
#pragma unroll
            for (int ee = 0; ee < 8; ++ee) { const unsigned long long m = __ballot(e == ee); if (e == ee) rk = __popcll(m & lt_mask); if (lane == 0) sm[32 + wave * 8 + ee] = __popcll(m); }
        }
        __syncthreads();
        if (tid < 256) {
            int r = sm[16 + e] + sm[8 + e] + rk;
            for (int w = 0; w < wave; ++w) r += sm[32 + w * 8 + e];
            ROWMAP[r] = tok; PSLOT[tok * 2 + k] = r;
        }
        if (ch < 8) { const int st = sm[16 + ch] + sm[ch], en = sm[16 + ch + 1]; for (int s = st + tid; s < en; s += NTHREADS) ROWMAP[s] = 0; }
        if (ch == 8) { for (int p = tid; p < 272; p += NTHREADS) { int ee = 0;
#pragma unroll
                for (int q = 1; q < 8; ++q) if (p * 256 >= sm[16 + q]) ee = q;
                PEXP[p] = ee; }
            if (tid == 0) PEXP[272] = sm[24] >> 8; }
        __syncthreads();
    }
}

constexpr int NPH = 23;
__global__ void __launch_bounds__(NTHREADS, 2) mk_fwd(Args args) {
    extern __shared__ __attribute__((aligned(16))) unsigned char lds[];
    Frame F;
    F.lds = (LAS unsigned char*)lds; F.MISC = (volatile LAS unsigned*)(F.lds + MISC_OFF);
    const int tid0 = threadIdx.x;
    F.G = gridDim.x; F.c = blockIdx.x;
    F.out = args.out; F.ws = args.ws;
    unsigned char* ws = args.ws;
    for (int u = tid0; u < (LDS_BYTES - RING_BYTES) / 4; u += NTHREADS) ((LAS unsigned*)(F.lds + RING_BYTES))[u] = 0u;
    __syncthreads();
    const int lo = args.ph_lo, hi = args.ph_hi;
    XcdBarrier bar; bar.bar = (unsigned*)(ws + WS_CTL) + CW_BAR; bar.x = 0; bar.st = nullptr;
    if (hi - lo > 1) bar = xcd_barrier_post((unsigned*)(ws + WS_CTL) + CW_BAR, F.MISC + 8);
    int ph = 0;
#ifndef MK_SITES
#define MK_SITES 0xffffu
#endif
#define PH_BEGIN(site) if (((MK_SITES >> (site)) & 1u) && ph >= lo && ph < hi) {
#define PH_END   if (ph + 1 < hi) xcd_barrier(bar); } ++ph;

    PH_BEGIN(0) p_conv(F); PH_END
    PH_BEGIN(1) p_h0(F); PH_END

    for (int l = 0; l < 2; ++l) {
        PH_BEGIN(2)
            pg8::SchedG S; S.o.init(l ? 128 : 136, 26, F.G, F.c); S.A = (const char*)(ws + WS_H); S.B = (const char*)(ws + (l ? WS_WIN1 : WS_WIN0));
            S.astep = 256 * DM * 2; S.bstep = 256 * DM * 2; S.nx = l ? 32 : 0;
            pg8::EpiZ E{ws};
            pg8::gemm_phase<pg8::EpiZ, pg8::SchedG, false, false>(F.lds, DM, DM, DM, S, E, 0, 0, nullptr);
        PH_END
        PH_BEGIN(3)
            p_convpool(F, l);
            p_attn(F, l, (char*)lds);
        PH_END
        PH_BEGIN(4)
            pg8::SchedG S; S.o.init(l ? 128 : 136, 4, F.G, F.c); S.A = (const char*)(ws + WS_AO); S.B = (const char*)(ws + (l ? WS_WM1 : WS_WM0));
            S.astep = 256 * 512 * 2; S.bstep = 256 * 1536 * 2; S.nx = 0;
            pg8::EpiMerge E{(bf16_t*)(ws + WS_MERGED), (const bf16_t*)(ws + WS_GT)};
            pg8::gemm_phase<pg8::EpiMerge, pg8::SchedG, true, false>(F.lds, 1536, 512, 1536, S, E, (long)WS_CB - (long)WS_AO, (long)WS_P - (long)WS_AO, nullptr);
        PH_END
        PH_BEGIN(5)
            pg8::SchedG S; S.o.init(l ? 128 : 136, 4, F.G, F.c); S.A = (const char*)(ws + WS_MERGED); S.B = (const char*)(ws + (l ? WS_WO1 : WS_WO0));
            S.astep = 256 * DM * 2; S.bstep = 256 * DM * 2; S.nx = 0;
            pg8::EpiPlain E{(bf16_t*)(ws + WS_MIX), DM};
            pg8::gemm_phase<pg8::EpiPlain, pg8::SchedG, false, false>(F.lds, DM, DM, DM, S, E, 0, 0, nullptr);
            if (l == 1) { __syncthreads(); p_conv_moe(F); }
        PH_END
        PH_BEGIN(6) p_nr1(F, l); PH_END
        if (l == 0) {
            PH_BEGIN(7)
                pg8::SchedG S; S.o.init(136, 22, F.G, F.c); S.A = (const char*)(ws + WS_H2_0); S.B = (const char*)(ws + WS_WGU);
                S.astep = 256 * DM * 2; S.bstep = 256 * DM * 2; S.nx = 0;
                pg8::EpiGlu E{(bf16_t*)(ws + WS_ACT0)};
                pg8::gemm_phase<pg8::EpiGlu, pg8::SchedG, false, false>(F.lds, DM, DM, DM, S, E, 0, 0, nullptr);
            PH_END
            PH_BEGIN(8)
                pg8::SchedG S; S.o.init(136, 4, F.G, F.c); S.A = (const char*)(ws + WS_ACT0); S.B = (const char*)(ws + WS_WD);
                S.astep = 256 * DFF * 2; S.bstep = 256 * DFF * 2; S.nx = 0;
                pg8::EpiPlain E{(bf16_t*)(ws + WS_F_0), DM};
                pg8::gemm_phase<pg8::EpiPlain, pg8::SchedG, false, false>(F.lds, DFF, DFF, DFF, S, E, 0, 0, nullptr);
            PH_END
        } else {
            PH_BEGIN(9) p_route(F); PH_END
            for (int ci = 0; ci < 3; ++ci) {
                PH_BEGIN(10)
                    const int np_all = __builtin_amdgcn_readfirstlane(((const int*)(ws + WS_PEXP))[272]);
                    int np = np_all - 128 * ci; np = np < 0 ? 0 : (np > 128 ? 128 : np);
                    if (np > 0) {
                        pg8::SchedMoe S; S.o.init(np, 22, F.G, F.c); S.p0 = 128 * ci; S.pexp = (const int*)(ws + WS_PEXP); S.A = (const char*)(ws + WS_H); S.astep = 0;
                        S.B = (const char*)(ws + WS_WMOE); S.estride = (int)MOE_ESTRIDE; S.bstep = 256 * DM * 2;
                        pg8::EpiGlu E{(bf16_t*)(ws + WS_ACT1)};
                        pg8::gemm_phase<pg8::EpiGlu, pg8::SchedMoe, false, true>(F.lds, DM, DM, DM, S, E, 0, 0, (const int*)(ws + WS_ROWMAP));
                    }
                PH_END
                PH_BEGIN(11)
                    const int np_all = __builtin_amdgcn_readfirstlane(((const int*)(ws + WS_PEXP))[272]);
                    int np = np_all - 128 * ci; np = np < 0 ? 0 : (np > 128 ? 128 : np);
                    if (np > 0) {
                        pg8::SchedMoe S; S.o.init(np, 4, F.G, F.c); S.p0 = 128 * ci; S.pexp = (const int*)(ws + WS_PEXP); S.A = (const char*)(ws + WS_ACT1); S.astep = 256 * DFF * 2;
                        S.B = (const char*)(ws + WS_WMOE + MOE_WD_OFF); S.estride = (int)MOE_ESTRIDE; S.bstep = 256 * DFF * 2;
                        pg8::EpiPlain E{(bf16_t*)(ws + WS_OUTP) + (size_t)ci * 32768 * DM, DM};
                        pg8::gemm_phase<pg8::EpiPlain, pg8::SchedMoe, false, false>(F.lds, DFF, DFF, DFF, S, E, 0, 0, nullptr);
                    }
                PH_END
            }
        }
        PH_BEGIN(12) p_nr2(F, l); PH_END
    }
#undef PH_BEGIN
#undef PH_END
}

extern "C" void kernel_launch(void* const* d_in, const int* in_sizes, int n_in, void* d_out, int out_size, void* d_ws, size_t ws_size, hipStream_t stream) {
    static int grid = 0;
    if (grid == 0) {
        if (n_in != 28 || in_sizes[0] != ML * DM || out_size != ML * DM || ws_size < WS_END) {
            fprintf(stderr, "kernel_launch: shape/workspace mismatch (n_in %d, ws %zu, need %zu); nothing launched\n", n_in, ws_size, (size_t)WS_END); grid = -1; return; }
        if (hipFuncSetAttribute((const void*)mk_fwd, hipFuncAttributeMaxDynamicSharedMemorySize, LDS_BYTES) != hipSuccess) { fprintf(stderr, "kernel_launch: hipFuncSetAttribute failed\n"); grid = -1; return; }
        int dev = 0, cus = 0, per_cu = 0;
        if (hipGetDevice(&dev) != hipSuccess || hipDeviceGetAttribute(&cus, hipDeviceAttributeMultiprocessorCount, dev) != hipSuccess) { grid = -1; return; }
        if (hipOccupancyMaxActiveBlocksPerMultiprocessor(&per_cu, (const void*)mk_fwd, NTHREADS, LDS_BYTES) != hipSuccess || per_cu < 1)
            fprintf(stderr, "kernel_launch: occupancy query reports %d\n", per_cu);
        (void)hipGetLastError();
        grid = cus;
        if (grid != 256) fprintf(stderr, "kernel_launch: %d CUs (built for 256)\n", grid);
    }
    if (grid < 0) return;
    if (hipMemsetAsync((char*)d_ws + WS_CTL, 0, CTL_ZERO_BYTES, stream) != hipSuccess) return;
    Args a{};
    for (int i = 0; i < 28; ++i) a.in[i] = (const float*)d_in[i];
    a.out = (float*)d_out; a.ws = (unsigned char*)d_ws;
#if MK_MULTI
    for (int p = 0; p < NPH; ++p) { a.ph_lo = p; a.ph_hi = p + 1; hipLaunchKernelGGL(mk_fwd, dim3(grid), dim3(NTHREADS), LDS_BYTES, stream, a); }
#else
    a.ph_lo = 0; a.ph_hi = NPH;
    hipLaunchKernelGGL(mk_fwd, dim3(grid), dim3(NTHREADS), LDS_BYTES, stream, a);
#endif
    const hipError_t le = hipPeekAtLastError();
    if (le != hipSuccess) fprintf(stderr, "kernel_launch: launch failed: %s\n", hipGetErrorName(le));
}
```

```cpp
#include <hip/hip_runtime.h>
#include <cstdio>
#include <cstdint>

#ifndef MK_MULTI
#define MK_MULTI 0
#endif

#define LAS __attribute__((address_space(3)))
#define GAS __attribute__((address_space(1)))
typedef unsigned short bf16_t;
typedef short bf16x8 __attribute__((ext_vector_type(8)));
typedef short s16x4 __attribute__((ext_vector_type(4)));
typedef float f32x2 __attribute__((ext_vector_type(2)));
typedef float f32x4 __attribute__((ext_vector_type(4)));
typedef float f32x16 __attribute__((ext_vector_type(16)));
typedef unsigned u32x2 __attribute__((ext_vector_type(2)));
typedef unsigned u32x4 __attribute__((ext_vector_type(4)));

constexpr int NB = 8, SEQ = 4096, DM = 1024, CTXL = 256;
constexpr int ML = NB * SEQ, MC = NB * CTXL, MT = ML + MC, TALL = SEQ + CTXL;
constexpr int INW = 6656, DFF = 2816, NE = 8;
constexpr float EPS = 1e-6f;
constexpr int NWAVES = 8, NTHREADS = 512;

constexpr size_t MiB = 1u << 20, HMiB = 1u << 19;
constexpr size_t WS_CTL = 0, CTL_ZERO_BYTES = 64 * 1024;
constexpr size_t WS_MOD = 1 * MiB;
constexpr size_t WS_ROPE = 1 * MiB + 512 * 1024;
constexpr size_t WS_LAM = WS_ROPE + 16384;
constexpr size_t WS_TKE = 2 * MiB;
constexpr size_t WS_TKP = 2 * MiB + 256 * 1024;
constexpr size_t WS_PSLOT = 2 * MiB + 512 * 1024;
constexpr size_t WS_ROWMAP = 2 * MiB + 768 * 1024;
constexpr size_t WS_CNT = 3 * MiB + 256 * 1024;
constexpr size_t WS_PEXP = 3 * MiB + 320 * 1024;
constexpr size_t WS_RSH = 3 * MiB + 400 * 1024;
constexpr size_t WS_RSH2 = 3 * MiB + 560 * 1024;
constexpr size_t WS_RSS = 3 * MiB + 704 * 1024;
constexpr size_t WS_Y = 4 * MiB;
constexpr size_t WS_WIN1 = 12 * MiB, WS_WM1 = 25 * MiB, WS_WO1 = 28 * MiB;
constexpr size_t WS_WIN0 = 30 * MiB, WS_WM0 = 43 * MiB, WS_WO0 = 46 * MiB, WS_WGU = 48 * MiB, WS_WD = 59 * MiB;
constexpr size_t WS_Q = 64 * MiB + HMiB, WS_K = WS_Q + 34 * MiB, WS_V = WS_K + 34 * MiB;
constexpr size_t WS_CB = WS_V + 34 * MiB, WS_U = WS_CB + 34 * MiB, WS_PIN = WS_U + 34 * MiB;
constexpr size_t WS_GT = WS_PIN + 34 * MiB;
constexpr size_t WS_H = WS_GT + 204 * MiB;
constexpr size_t WS_AO = WS_H, WS_P = WS_H + 34 * MiB;
constexpr size_t WS_END = WS_H + 68 * MiB;
constexpr size_t WS_MERGED = WS_Q;
constexpr size_t WS_MIX = WS_U;
constexpr size_t WS_H2_0 = WS_GT;
constexpr size_t WS_F_0 = WS_GT + 34 * MiB;
constexpr size_t WS_ACT0 = WS_Q;
constexpr size_t WS_WMOE = 320 * MiB;
constexpr size_t WS_X16 = 408 * MiB;
constexpr size_t MOE_ESTRIDE = 11 * MiB, MOE_WD_OFF = 5 * MiB + HMiB;
constexpr size_t WS_CONVO1 = 30 * MiB;
constexpr size_t WS_ACT1 = 12 * MiB;
constexpr size_t WS_OUTP = 200 * MiB;
static_assert(WS_OUTP + 132 * MiB <= WS_X16 && WS_ACT1 + 187 * MiB <= WS_OUTP && WS_X16 + 64 * MiB <= WS_H && WS_F_0 + 68 * MiB <= WS_X16 && WS_GT + 102 * MiB <= WS_X16, "moe / residual map");
static_assert(WS_ACT0 + (size_t)MT * DFF * 2 <= WS_H2_0, "dense act map");

constexpr int CW_TMO = 0;
constexpr int CW_BAR = 1024;

constexpr int RING_BYTES = 131072;
constexpr int MISC_OFF = RING_BYTES + 320;
constexpr int LDS_BYTES = 147456;

#define LDS_WAIT() asm volatile("s_waitcnt lgkmcnt(0)" ::: "memory")
#define VM_WAIT() asm volatile("s_waitcnt vmcnt(0)" ::: "memory")
__device__ __forceinline__ unsigned cvt_pk_bf16(float lo, float hi) { unsigned r; asm volatile("v_cvt_pk_bf16_f32 %0, %1, %2" : "=v"(r) : "v"(lo), "v"(hi)); return r; }
__device__ __forceinline__ float bf_lo(unsigned u) { return __uint_as_float(u << 16); }
__device__ __forceinline__ float bf_hi(unsigned u) { return __uint_as_float(u & 0xffff0000u); }
__device__ __forceinline__ float wave_sum(float v) {
#pragma unroll
    for (int o = 1; o < 64; o <<= 1) v += __shfl_xor(v, o);
    return v;
}
__device__ __forceinline__ void st_agent(float* p, float v) { __hip_atomic_store(p, v, __ATOMIC_RELAXED, __HIP_MEMORY_SCOPE_AGENT); }
__device__ __forceinline__ void st_agent(int* p, int v) { __hip_atomic_store(p, v, __ATOMIC_RELAXED, __HIP_MEMORY_SCOPE_AGENT); }
__device__ __forceinline__ float ld_agent(const float* p) { return __hip_atomic_load(p, __ATOMIC_RELAXED, __HIP_MEMORY_SCOPE_AGENT); }
__device__ __forceinline__ int ld_agent(const int* p) { return __hip_atomic_load(p, __ATOMIC_RELAXED, __HIP_MEMORY_SCOPE_AGENT); }
__device__ __forceinline__ float fast_rcp(float x) { return __builtin_amdgcn_rcpf(x); }
__device__ __forceinline__ float sigmoid_c(float x) { x = fminf(fmaxf(x, -30.f), 30.f); return fast_rcp(1.f + __builtin_amdgcn_exp2f(-1.4426950408889634f * x)); }
__device__ __forceinline__ float silu_f(float x) { return x * fast_rcp(1.f + __builtin_amdgcn_exp2f(-1.4426950408889634f * x)); }

#define XB_TMO      128
#define XB_XCNT(j)  (256  + 64 * (j))
#define XB_XSUB(j)  (1280 + 64 * (j))
#define XB_XGEN(j)  (2304 + 64 * (j))
#define XB_TOP      3328
#define XB_TOPGEN   3392
#define XCD_BAR_WORDS 3456
#define XB_SPIN_CAP (1u << 20)
__device__ __forceinline__ unsigned xb_ld(unsigned* p)              { return __hip_atomic_load(p, __ATOMIC_RELAXED, __HIP_MEMORY_SCOPE_AGENT); }
__device__ __forceinline__ unsigned xb_add(unsigned* p, unsigned v) { return __hip_atomic_fetch_add(p, v, __ATOMIC_RELAXED, __HIP_MEMORY_SCOPE_AGENT); }
__device__ __forceinline__ unsigned xb_xcc_id() { return (unsigned)__builtin_amdgcn_s_getreg((3 << 11) | 20) & 0xFu; }
#define XB_SPIN(cond, bar) do { unsigned _sp = 0; while (cond) { __builtin_amdgcn_s_sleep(1); \
    if ((++_sp & 255u) == 0u) { if (xb_ld(&(bar)[XB_TMO])) break; if (_sp > XB_SPIN_CAP) { atomicAdd(&(bar)[XB_TMO], 1u); break; } } } } while (0)
struct XcdBarrier { unsigned* bar; unsigned x; volatile LAS unsigned* st; };
__device__ __forceinline__ XcdBarrier xcd_barrier_post(unsigned* bar, volatile LAS unsigned* st) {
    XcdBarrier b; b.bar = bar; b.x = xb_xcc_id(); b.st = st;
    if (threadIdx.x == 0) (void)xb_add(&bar[XB_XCNT(b.x)], 1u);
    return b;
}
__device__ __forceinline__ void xcd_barrier_complete(unsigned* bar, unsigned x, unsigned& nloc, unsigned& nx) {
    const unsigned G = gridDim.x * gridDim.y * gridDim.z;
    unsigned sum, cnt, mine, sp = 0u;
    for (;;) {
        sum = 0u; cnt = 0u; mine = 0u;
#pragma unroll
        for (unsigned j = 0; j < 16; ++j) { const unsigned c = xb_ld(&bar[XB_XCNT(j)]); sum += c; cnt += (c > 0u) ? 1u : 0u; mine = (j == x) ? c : mine; }
        if (sum == G) break;
        __builtin_amdgcn_s_sleep(1);
        if ((++sp & 255u) == 0u) { if (xb_ld(&bar[XB_TMO])) break; if (sp > XB_SPIN_CAP) { atomicAdd(&bar[XB_TMO], 1u); break; } }
    }
    nloc = mine > 0u ? mine : 1u; nx = cnt > 0u ? cnt : 1u;
}
__device__ __forceinline__ void xcd_barrier(const XcdBarrier& b) {
    asm volatile("s_waitcnt vmcnt(0)" ::: "memory");
    __syncthreads();
    if (threadIdx.x == 0) {
        unsigned* bar = b.bar;
        __builtin_amdgcn_s_waitcnt(0);
        unsigned nloc = b.st[0], nx = b.st[1];
        if (nloc == 0u) { xcd_barrier_complete(bar, b.x, nloc, nx); b.st[0] = nloc; b.st[1] = nx; }
        const unsigned old = xb_add(&bar[XB_XSUB(b.x)], 1u);
        const unsigned gen = old / nloc;
        if (old + 1u == (gen + 1u) * nloc) {
            __builtin_amdgcn_fence(__ATOMIC_RELEASE, "agent");
            asm volatile("s_waitcnt vmcnt(0)" ::: "memory");
            const unsigned og = xb_add(&bar[XB_TOP], 1u);
            const unsigned tg = og / nx;
            if (og + 1u == (tg + 1u) * nx) xb_add(&bar[XB_TOPGEN], 1u);
            else XB_SPIN(xb_ld(&bar[XB_TOPGEN]) == tg, bar);
            __builtin_amdgcn_fence(__ATOMIC_ACQUIRE, "agent");
            xb_add(&bar[XB_XGEN(b.x)], 1u);
            asm volatile("s_waitcnt vmcnt(0)" ::: "memory");
        } else {
            XB_SPIN(xb_ld(&bar[XB_XGEN(b.x)]) == gen, bar);
            __builtin_amdgcn_fence(__ATOMIC_ACQUIRE, "agent");
            asm volatile("s_waitcnt vmcnt(0)" ::: "memory");
        }
    }
    __syncthreads();
}

namespace pg8 {
constexpr int BM = 256, BK = 64, HALF = 128, HTB = HALF * BK * 2, STAGE_BYTES = 8 * HTB, NXCD = 8, WGM = 8;
__device__ __forceinline__ int lds_byte(int r, int c) { const int st = (r >> 4) * 2 + (c >> 5), rr = r & 15, cc = c & 31, ob = rr * 64 + cc * 2; return st * 1024 + (ob ^ (((ob >> 9) & 1) << 5)); }
__device__ __forceinline__ void stage_rc(int b, int& R, int& C) { const int st = b / 1024, sb = b % 1024, swz = sb ^ (((sb >> 9) & 1) << 5); R = (st >> 1) * 16 + swz / 64; C = (st & 1) * 32 + (swz % 64) / 2; }
__device__ __forceinline__ int perm32(int rho) { const int n = rho >> 4, i = rho & 15; return 8 * (i >> 2) + 4 * n + (i & 3); }

typedef int i32x4 __attribute__((ext_vector_type(4)));
typedef int i32x8 __attribute__((ext_vector_type(8)));
struct Unit { int pm, pn, aux; const char* A; const char* B; };

struct TileOrder {
    int nM, nN, nwg, G, c;
    __device__ __forceinline__ void init(int nM_, int nN_, int G_, int c_) { nM = nM_; nN = nN_; nwg = nM * nN; G = G_; c = c_; }
    __device__ __forceinline__ void tile(int L, int& pm, int& pn) const {
        int wgid = L; { const int q = nwg / NXCD, r = nwg % NXCD, xcd = wgid % NXCD, off = wgid / NXCD; wgid = (xcd < r ? xcd * (q + 1) : r * (q + 1) + (xcd - r) * q) + off; }
        const int nig = WGM * nN, gid = wgid / nig, fm = gid * WGM, gsz = (nM - fm) < WGM ? (nM - fm) : WGM;
        pm = fm + ((wgid % nig) % gsz); pn = (wgid % nig) / gsz;
    }
};

template <class Epi, class Sched, bool KSEG, bool GATHER, bool I8 = false>
__device__ __forceinline__ void gemm_phase(LAS unsigned char* lds, const int K, const int lda, const int ldb, const Sched& S, const Epi& E,
                                           const long segoff1, const long segoff2, const int* __restrict__ rowmap) {
    int tid = threadIdx.x; asm volatile("" : "+v"(tid));
    const int wid = __builtin_amdgcn_readfirstlane(tid >> 6), lane = tid & 63, wr = wid >> 2, wc = wid & 3, fr = lane & 15, fq = lane >> 4;
    const int nt = K / BK;
    int Rr[2], Cc[2];
    unsigned voffB[2], vaC[2][2], vaN[2][2];
    const size_t hstepB = (size_t)HALF * ldb * 2;
#pragma unroll
    for (int i = 0; i < 2; ++i) { stage_rc(tid * 16 + i * 8192, Rr[i], Cc[i]); const int Rb = (Rr[i] & ~31) + perm32(Rr[i] & 31);
        voffB[i] = (unsigned)(Rb * ldb + Cc[i]) * 2u;
#pragma unroll
        for (int h = 0; h < 2; ++h) { vaC[h][i] = (unsigned)((h * HALF + Rr[i]) * lda + Cc[i]) * 2u; vaN[h][i] = vaC[h][i]; } }
    const unsigned ldsw = (unsigned)wid * 1024u;
    const int aoff = lds_byte(wr * 64 + fr, fq * 8), boff = lds_byte(wc * 32 + fr, fq * 8);
#define PG8_SA(b, h) (((b) * 2 + (h)) * HTB)
#define PG8_SB(b, h) ((4 + (b) * 2 + (h)) * HTB)
#define PG8_STAGE(bufoff, gbase, voff) do { const char* gb_ = (const char*)(gbase); asm volatile("" : "+s"(gb_));     \
        _Pragma("unroll") for (int _i = 0; _i < 2; ++_i) \
        __builtin_amdgcn_global_load_lds((const unsigned*)(gb_ + (voff)[_i]), (LAS unsigned*)(lds + (bufoff) + ldsw + _i * 8192), 16, 0, 0); } while (0)
#define PG8_LDA(dst, b, h) do { _Pragma("unroll") for (int m = 0; m < 4; ++m) _Pragma("unroll") for (int k = 0; k < 2; ++k) dst[m][k] = *(const LAS bf16x8*)(lds + PG8_SA(b, h) + aoff + m * 2048 + k * 1024); } while (0)
#define PG8_LDB(dst, b, h) do { _Pragma("unroll") for (int n = 0; n < 2; ++n) _Pragma("unroll") for (int k = 0; k < 2; ++k) dst[n][k] = *(const LAS bf16x8*)(lds + PG8_SB(b, h) + boff + n * 2048 + k * 1024); } while (0)
#define PG8_MMA(ai, bj, At, Bt) do { __builtin_amdgcn_s_setprio(1); _Pragma("unroll") for (int m = 0; m < 4; ++m) _Pragma("unroll") for (int n = 0; n < 2; ++n) _Pragma("unroll") for (int k = 0; k < 2; ++k) { \
        if constexpr (I8) acc[ai][bj][m][n] = __builtin_bit_cast(f32x4, __builtin_amdgcn_mfma_i32_16x16x64_i8(__builtin_bit_cast(i32x4, Bt[n][k]), __builtin_bit_cast(i32x4, At[m][k]), __builtin_bit_cast(i32x4, acc[ai][bj][m][n]), 0, 0, 0)); \
        else acc[ai][bj][m][n] = __builtin_amdgcn_mfma_f32_16x16x32_bf16(Bt[n][k], At[m][k], acc[ai][bj][m][n], 0, 0, 0); } __builtin_amdgcn_s_setprio(0); } while (0)
#define PG8_WAIT_V(n) asm volatile("s_waitcnt vmcnt(" #n ")" ::: "memory")
#define PG8_WAIT_L(n) asm volatile("s_waitcnt lgkmcnt(" #n ")" ::: "memory")
#define PG8_BAR __builtin_amdgcn_s_barrier()
#define PG8_SCHED __builtin_amdgcn_sched_barrier(0)
#define PG8_KOFF(t) (KSEG ? ((long)(((t) >> 3) == 0 ? 0L : (((t) >> 3) == 1 ? segoff1 : segoff2)) + (long)((t) & 7) * 128L) : (long)(t) * 128L)
#define PG8_GATHER(dst, u) do { if constexpr (GATHER) { _Pragma("unroll") for (int _h = 0; _h < 2; ++_h) _Pragma("unroll") for (int _i = 0; _i < 2; ++_i) \
        dst[_h][_i] = (unsigned)(ld_agent(rowmap + (u).aux * 256 + _h * HALF + Rr[_i]) * lda + Cc[_i]) * 2u; } } while (0)
    Unit cur, nxt; int ui = 0;
    if (!S.next(0, cur)) return;
    f32x4 acc[2][2][4][2];
#pragma unroll
    for (int a = 0; a < 2; ++a)
#pragma unroll
        for (int b = 0; b < 2; ++b)
#pragma unroll
            for (int m = 0; m < 4; ++m)
#pragma unroll
                for (int n = 0; n < 2; ++n) acc[a][b][m][n] = (f32x4){0.f, 0.f, 0.f, 0.f};
    bf16x8 At[4][2], B0[2][2], B1[2][2];
    const char* cA = cur.A; const char* cB = cur.B;
    PG8_GATHER(vaC, cur);
    PG8_STAGE(PG8_SB(0, 0), cB, voffB); PG8_STAGE(PG8_SB(0, 1), cB + hstepB, voffB); PG8_STAGE(PG8_SA(0, 0), cA, vaC[0]); PG8_STAGE(PG8_SA(0, 1), cA, vaC[1]);
    if (wr == 1) PG8_BAR;
    PG8_WAIT_V(2); PG8_BAR;
    PG8_STAGE(PG8_SB(1, 0), cB + 128, voffB); PG8_STAGE(PG8_SA(1, 0), cA + PG8_KOFF(1), vaC[0]); PG8_STAGE(PG8_SB(1, 1), cB + hstepB + 128, voffB);
    PG8_WAIT_V(6); PG8_BAR;
    for (;;) {
        const bool has_next = S.next(ui + 1, nxt);
        const char* nA = has_next ? nxt.A : cA; const char* nB = has_next ? nxt.B : cB;
        if constexpr (GATHER) { if (has_next) { PG8_GATHER(vaN, nxt); } else {
#pragma unroll
            for (int h = 0; h < 2; ++h)
#pragma unroll
                for (int i = 0; i < 2; ++i) vaN[h][i] = vaC[h][i]; } }
        const int tchunk = Epi::MIDK ? 8 : nt;
        for (int t0 = 0; t0 < nt; t0 += tchunk) {
        if constexpr (Epi::MIDK) { if (t0 > 0) { PG8_SCHED; E.rescale(acc, cur, (t0 >> 3) - 1, wr, wc, fr, fq); PG8_SCHED; } }
        for (int t = t0; t < t0 + tchunk; t += 2) {
            const bool last = (t == nt - 2);
            const char* a1 = cA + PG8_KOFF(t + 1);
            const char* a2 = last ? nA : cA + PG8_KOFF(t + 2); const char* b2 = last ? nB : cB + (size_t)(t + 2) * 128;
            const char* a3 = last ? nA + PG8_KOFF(1) : cA + PG8_KOFF(t + 3); const char* b3 = b2 + 128;
            unsigned v20[2], v21[2];
#pragma unroll
            for (int i = 0; i < 2; ++i) { v20[i] = (GATHER && last) ? vaN[0][i] : vaC[0][i]; v21[i] = (GATHER && last) ? vaN[1][i] : vaC[1][i]; }
            PG8_LDB(B0, 0, 0); PG8_LDB(B1, 0, 1); PG8_SCHED; PG8_LDA(At, 0, 0); PG8_STAGE(PG8_SA(1, 1), a1, vaC[1]);
            PG8_WAIT_V(8); PG8_WAIT_L(0); PG8_BAR; PG8_MMA(0, 0, At, B0); PG8_MMA(0, 1, At, B1); PG8_BAR; PG8_SCHED;
            PG8_LDA(At, 0, 1); PG8_STAGE(PG8_SB(0, 0), b2, voffB); PG8_STAGE(PG8_SB(0, 1), b2 + hstepB, voffB); PG8_STAGE(PG8_SA(0, 0), a2, v20);
            PG8_WAIT_V(8); PG8_WAIT_L(0); PG8_BAR; PG8_MMA(1, 0, At, B0); PG8_MMA(1, 1, At, B1); PG8_BAR; PG8_SCHED;
            PG8_LDB(B0, 1, 0); PG8_LDB(B1, 1, 1); PG8_SCHED; PG8_LDA(At, 1, 0); PG8_STAGE(PG8_SA(0, 1), a2, v21);
            PG8_WAIT_V(8); PG8_WAIT_L(0); PG8_BAR; PG8_MMA(0, 0, At, B0); PG8_MMA(0, 1, At, B1); PG8_BAR; PG8_SCHED;
            PG8_LDA(At, 1, 1); PG8_STAGE(PG8_SB(1, 0), b3, voffB); PG8_STAGE(PG8_SB(1, 1), b3 + hstepB, voffB); PG8_STAGE(PG8_SA(1, 0), a3, v20);
            PG8_WAIT_V(8); PG8_WAIT_L(0); PG8_BAR; PG8_MMA(1, 0, At, B0); PG8_MMA(1, 1, At, B1); PG8_BAR; PG8_SCHED;
        }
        }
        if (wr == 0) PG8_BAR;
        E(acc, cur, wr, wc, fr, fq);
        if (!has_next) break;
#pragma unroll
        for (int a = 0; a < 2; ++a)
#pragma unroll
            for (int b = 0; b < 2; ++b)
#pragma unroll
                for (int m = 0; m < 4; ++m)
#pragma unroll
                    for (int n = 0; n < 2; ++n) acc[a][b][m][n] = (f32x4){0.f, 0.f, 0.f, 0.f};
        cur = nxt; cA = nA; cB = nB; ++ui;
        if constexpr (GATHER) {
#pragma unroll
            for (int h = 0; h < 2; ++h)
#pragma unroll
                for (int i = 0; i < 2; ++i) vaC[h][i] = vaN[h][i]; }
        if (wr == 1) PG8_BAR;
    }
    PG8_WAIT_V(0);
    PG8_BAR;
#undef PG8_SA
#undef PG8_SB
#undef PG8_STAGE
#undef PG8_LDA
#undef PG8_LDB
#undef PG8_MMA
#undef PG8_WAIT_V
#undef PG8_WAIT_L
#undef PG8_BAR
#undef PG8_SCHED
#undef PG8_KOFF
#undef PG8_GATHER
}

struct SchedG {
    TileOrder o; const char* A; const char* B; int astep, bstep; int nx;
    __device__ __forceinline__ bool next(int i, Unit& u) const {
        const long L = (long)i * o.G + o.c;
        if (L < o.nwg) { o.tile((int)L, u.pm, u.pn); }
        else { const int x = (int)(L - o.nwg); if (x >= nx) return false; u.pm = 128 + (x >> 2); u.pn = 2 + (x & 3); }
        u.aux = u.pm; u.A = A + (size_t)u.pm * astep; u.B = B + (size_t)u.pn * bstep; return true;
    }
};
struct SchedMoe {
    TileOrder o; int p0, nmain, ptail; const int* pexp; const char* A; int astep; const char* B; int estride, bstep;
    int own; long extraL;
    __device__ __forceinline__ bool next(int i, Unit& u) const {
        long L;
        if (i < own) L = (long)i * o.G + o.c; else if (i == own && extraL >= 0) L = extraL; else return false;
        if (L >= o.nwg) return false;
        o.tile((int)L, u.pm, u.pn);
        u.aux = u.pm < nmain ? p0 + u.pm : ptail + (u.pm - nmain);
        const int e = __builtin_amdgcn_readfirstlane(pexp[u.aux]);
        u.A = A + (size_t)u.pm * astep; u.B = B + (size_t)e * estride + (size_t)u.pn * bstep; return true;
    }
};
struct SchedOne {
    bool has; Unit u0;
    __device__ __forceinline__ bool next(int i, Unit& u) const { if (i != 0 || !has) return false; u = u0; return true; }
};

typedef f32x4 Acc[2][2][4][2];
__device__ __forceinline__ u32x4 pack8(const f32x4 v0, const f32x4 v1) { u32x4 w; w.x = cvt_pk_bf16(v0[0], v0[1]); w.y = cvt_pk_bf16(v0[2], v0[3]); w.z = cvt_pk_bf16(v1[0], v1[1]); w.w = cvt_pk_bf16(v1[2], v1[3]); return w; }

template <bool I8> struct EpiZ {
    static constexpr bool MIDK = false;
    static __device__ __forceinline__ f32x4 val(const f32x4& a, const float S) { if constexpr (I8) { const i32x4 q = __builtin_bit_cast(i32x4, a); return (f32x4){(float)q[0] * S, (float)q[1] * S, (float)q[2] * S, (float)q[3] * S}; } else return a; }
    unsigned char* ws;
    __device__ __forceinline__ void rescale(Acc&, const Unit&, int, int, int, int, int) const {}
    __device__ __forceinline__ void operator()(const Acc& acc, const Unit& u, int wr, int wc, int fr, int fq) const {
        const int pm = u.pm, pn = u.pn; const bool isctx = pm >= 128;
        bf16_t* const Q = (bf16_t*)(ws + WS_Q); bf16_t* const Kb = (bf16_t*)(ws + WS_K); bf16_t* const Vb = (bf16_t*)(ws + WS_V); bf16_t* const CB = (bf16_t*)(ws + WS_CB);
        bf16_t* const U = (bf16_t*)(ws + WS_U); bf16_t* const PIN = (bf16_t*)(ws + WS_PIN); bf16_t* const GT = (bf16_t*)(ws + WS_GT);
        const float* const ropeC = (const float*)(ws + WS_ROPE); const float* const ropeS = ropeC + 1024;
        int mode, pitch = 512, colt; bf16_t* base; bool krow = false;
        if (pn < 2) { mode = isctx ? 0 : 1; base = Q; colt = 256 * pn; }
        else if (pn < 4) { mode = isctx ? 0 : 1; base = Kb; colt = 256 * (pn - 2); krow = true; }
        else if (pn < 6) { mode = 0; base = Vb; colt = 256 * (pn - 4); krow = true; }
        else if (pn < 8) { mode = 0; base = CB; colt = 256 * (pn - 6); }
        else if (pn < 12) { mode = 2; base = U; colt = 128 * (pn - 8); }
        else if (pn < 14) { mode = 0; base = PIN; colt = 256 * (pn - 12); }
        else { mode = 3; base = GT; pitch = 1536; colt = 128 * (pn - 14); }
        const long rowbase = krow ? (isctx ? (long)(pm - 128) * TALL : (long)(pm >> 4) * TALL + CTXL + (pm & 15) * 256) : (long)pm * 256;
        const int cl = wc * 32 + 8 * fq;
#pragma unroll
        for (int ai = 0; ai < 2; ++ai)
#pragma unroll
            for (int m = 0; m < 4; ++m) {
                const int rl = ai * 128 + wr * 64 + m * 16 + fr;
                const float S = (I8 ? (1.0f / (24.0f * 1024.0f)) : 1.0f) * (pn < 2 ? 0.18033688011112042f : 1.0f);
                bf16_t* rowp = base + (size_t)(rowbase + rl) * pitch + colt + cl;
                if (mode == 2) {
                    const f32x4 a0 = val(acc[ai][0][m][0], S) * val(acc[ai][1][m][0], S), a1 = val(acc[ai][0][m][1], S) * val(acc[ai][1][m][1], S);
                    *(u32x4*)rowp = pack8(a0, a1);
                } else if (mode == 1) {
                    const int pos = (wc & 1) ? (m * 16 + fr) : ((pm & 15) * 4 + 2 * ai + wr);
                    const f32x4 cs = *(const f32x4*)(ropeC + pos * 16 + 4 * fq), sn = *(const f32x4*)(ropeS + pos * 16 + 4 * fq);
#pragma unroll
                    for (int bj = 0; bj < 2; ++bj) { const f32x4 v0 = val(acc[ai][bj][m][0], S), v1 = val(acc[ai][bj][m][1], S);
                        *(u32x4*)(rowp + bj * 128) = pack8(v0 * cs - v1 * sn, v1 * cs + v0 * sn); }
                } else if (mode == 3) {
#pragma unroll
                    for (int bj = 0; bj < 2; ++bj) { f32x4 v0 = val(acc[ai][bj][m][0], S), v1 = val(acc[ai][bj][m][1], S);
#pragma unroll
                        for (int j = 0; j < 4; ++j) { v0[j] = fmaxf(255.0f * fast_rcp(1.f + __builtin_amdgcn_exp2f(-1.4426950408889634f * v0[j])), 1.0f); v1[j] = fmaxf(255.0f * fast_rcp(1.f + __builtin_amdgcn_exp2f(-1.4426950408889634f * v1[j])), 1.0f); }
                        u32x2 w; w.x = __builtin_amdgcn_cvt_pk_u8_f32(v0[3], 3, __builtin_amdgcn_cvt_pk_u8_f32(v0[2], 2, __builtin_amdgcn_cvt_pk_u8_f32(v0[1], 1, __builtin_amdgcn_cvt_pk_u8_f32(v0[0], 0, 0u))));
                        w.y = __builtin_amdgcn_cvt_pk_u8_f32(v1[3], 3, __builtin_amdgcn_cvt_pk_u8_f32(v1[2], 2, __builtin_amdgcn_cvt_pk_u8_f32(v1[1], 1, __builtin_amdgcn_cvt_pk_u8_f32(v1[0], 0, 0u))));
                        *(u32x2*)((unsigned char*)(base + (size_t)(rowbase + rl) * pitch + colt) + cl + bj * 128) = w; }
                } else {
#pragma unroll
                    for (int bj = 0; bj < 2; ++bj) *(u32x4*)(rowp + bj * 128) = pack8(val(acc[ai][bj][m][0], S), val(acc[ai][bj][m][1], S));
                }
                asm volatile("" ::: "memory");
            }
    }
};
struct EpiPlain {
    static constexpr bool MIDK = false;
    bf16_t* O; int ldc; float scale;
    __device__ __forceinline__ void rescale(Acc&, const Unit&, int, int, int, int, int) const {}
    __device__ __forceinline__ void operator()(const Acc& acc, const Unit& u, int wr, int wc, int fr, int fq) const {
        const int cl = u.pn * 256 + wc * 32 + 8 * fq;
#pragma unroll
        for (int ai = 0; ai < 2; ++ai)
#pragma unroll
            for (int m = 0; m < 4; ++m) { bf16_t* rowp = O + (size_t)(u.pm * 256 + ai * 128 + wr * 64 + m * 16 + fr) * ldc + cl;
#pragma unroll
                for (int bj = 0; bj < 2; ++bj) *(u32x4*)(rowp + bj * 128) = pack8(acc[ai][bj][m][0] * scale, acc[ai][bj][m][1] * scale); }
    }
};
struct EpiGlu {
    static constexpr bool MIDK = false;
    bf16_t* O;
    __device__ __forceinline__ void rescale(Acc&, const Unit&, int, int, int, int, int) const {}
    __device__ __forceinline__ void operator()(const Acc& acc, const Unit& u, int wr, int wc, int fr, int fq) const {
        const int cl = u.pn * 128 + wc * 32 + 8 * fq;
#pragma unroll
        for (int ai = 0; ai < 2; ++ai)
#pragma unroll
            for (int m = 0; m < 4; ++m) { bf16_t* rowp = O + (size_t)(u.pm * 256 + ai * 128 + wr * 64 + m * 16 + fr) * DFF + cl;
                f32x4 g0 = acc[ai][0][m][0], g1 = acc[ai][0][m][1];
#pragma unroll
                for (int j = 0; j < 4; ++j) { g0[j] = silu_f(g0[j]); g1[j] = silu_f(g1[j]); }
                *(u32x4*)rowp = pack8(g0 * acc[ai][1][m][0], g1 * acc[ai][1][m][1]); }
    }
};
__device__ __forceinline__ unsigned pk_i8x4(float a, float b, float c, float d) {
    const int qa = (int)rintf(fminf(fmaxf(a, -127.f), 127.f)), qb = (int)rintf(fminf(fmaxf(b, -127.f), 127.f)), qc = (int)rintf(fminf(fmaxf(c, -127.f), 127.f)), qd = (int)rintf(fminf(fmaxf(d, -127.f), 127.f));
    return (unsigned)(qa & 255) | ((unsigned)(qb & 255) << 8) | ((unsigned)(qc & 255) << 16) | ((unsigned)qd << 24);
}
constexpr float I8_SW = 1024.0f;
struct EpiGluI8 {
    static constexpr bool MIDK = false;
    bf16_t* O; const float* rs;
    __device__ __forceinline__ void rescale(Acc&, const Unit&, int, int, int, int, int) const {}
    __device__ __forceinline__ void operator()(const Acc& acc, const Unit& u, int wr, int wc, int fr, int fq) const {
        const int cl = u.pn * 128 + wc * 32 + 8 * fq;
        float Sv[2][4];
#pragma unroll
        for (int ai = 0; ai < 2; ++ai)
#pragma unroll
            for (int m = 0; m < 4; ++m) Sv[ai][m] = ld_agent(rs + u.aux * 256 + ai * 128 + wr * 64 + m * 16 + fr);
        asm volatile("s_waitcnt vmcnt(0)" ::: "memory"); __builtin_amdgcn_sched_barrier(0);
#pragma unroll
        for (int ai = 0; ai < 2; ++ai)
#pragma unroll
            for (int m = 0; m < 4; ++m) { bf16_t* rowp = O + (size_t)(u.pm * 256 + ai * 128 + wr * 64 + m * 16 + fr) * DFF + cl;
                const float S = Sv[ai][m] * (1.0f / I8_SW);
                f32x4 g0, g1, u0, u1;
#pragma unroll
                for (int j = 0; j < 4; ++j) { g0[j] = silu_f((float)__builtin_bit_cast(i32x4, acc[ai][0][m][0])[j] * S); g1[j] = silu_f((float)__builtin_bit_cast(i32x4, acc[ai][0][m][1])[j] * S);
                    u0[j] = (float)__builtin_bit_cast(i32x4, acc[ai][1][m][0])[j] * S; u1[j] = (float)__builtin_bit_cast(i32x4, acc[ai][1][m][1])[j] * S; }
                *(u32x4*)rowp = pack8(g0 * u0, g1 * u1); }
    }
};
struct EpiMerge {
    static constexpr bool MIDK = true;
    bf16_t* O; const unsigned char* GT;
    static __device__ __forceinline__ f32x4 ub4(unsigned w) { return (f32x4){(float)(w & 255u), (float)((w >> 8) & 255u), (float)((w >> 16) & 255u), (float)(w >> 24)}; }
    __device__ __forceinline__ void rescale(Acc& acc, const Unit& u, int j, int wr, int wc, int fr, int fq) const {
        const int cl = u.pn * 256 + wc * 32 + 8 * fq;
#pragma unroll
        for (int ai = 0; ai < 2; ++ai) {
            u32x2 ga[4][2], gb[4][2];
#pragma unroll
            for (int m = 0; m < 4; ++m) { const unsigned char* gp = GT + (size_t)(u.pm * 256 + ai * 128 + wr * 64 + m * 16 + fr) * 3072 + j * 1024 + cl;
#pragma unroll
                for (int bj = 0; bj < 2; ++bj) { ga[m][bj] = *(const u32x2*)(gp + bj * 128); gb[m][bj] = *(const u32x2*)(gp + 1024 + bj * 128); } }
            asm volatile("s_waitcnt vmcnt(0)" ::: "memory"); __builtin_amdgcn_sched_barrier(0);
#pragma unroll
            for (int m = 0; m < 4; ++m)
#pragma unroll
                for (int bj = 0; bj < 2; ++bj) { const u32x2 a = ga[m][bj], b = gb[m][bj];
                    const f32x4 a0 = ub4(a.x), a1 = ub4(a.y), b0 = ub4(b.x), b1 = ub4(b.y);
                    f32x4 r0, r1;
#pragma unroll
                    for (int i = 0; i < 4; ++i) { r0[i] = a0[i] * fast_rcp(b0[i]); r1[i] = a1[i] * fast_rcp(b1[i]); }
                    acc[ai][bj][m][0] *= r0; acc[ai][bj][m][1] *= r1; }
            __builtin_amdgcn_sched_barrier(0);
        }
    }
    __device__ __forceinline__ void operator()(const Acc& acc, const Unit& u, int wr, int wc, int fr, int fq) const {
        const int cl = u.pn * 256 + wc * 32 + 8 * fq;
        u32x2 ga[2][4][2];
#pragma unroll
        for (int ai = 0; ai < 2; ++ai)
#pragma unroll
            for (int m = 0; m < 4; ++m) { const unsigned char* gp = GT + (size_t)(u.pm * 256 + ai * 128 + wr * 64 + m * 16 + fr) * 3072 + 2048 + cl;
#pragma unroll
                for (int bj = 0; bj < 2; ++bj) ga[ai][m][bj] = *(const u32x2*)(gp + bj * 128); }
        asm volatile("s_waitcnt vmcnt(0)" ::: "memory"); __builtin_amdgcn_sched_barrier(0);
#pragma unroll
        for (int ai = 0; ai < 2; ++ai)
#pragma unroll
            for (int m = 0; m < 4; ++m) { const size_t row = (size_t)(u.pm * 256 + ai * 128 + wr * 64 + m * 16 + fr);
                bf16_t* rowp = O + row * 1024 + cl;
#pragma unroll
                for (int bj = 0; bj < 2; ++bj) { const u32x2 a = ga[ai][m][bj];
                    const f32x4 g0 = ub4(a.x) * (1.0f / 255.0f), g1 = ub4(a.y) * (1.0f / 255.0f);
                    *(u32x4*)(rowp + bj * 128) = pack8(acc[ai][bj][m][0] * g0, acc[ai][bj][m][1] * g1); }
                }
    }
};
}

namespace att {
constexpr int KVBLK = 64;
constexpr float SCALE = 0.125f, THR = 8.f;
constexpr int LDQ = 512;
constexpr size_t SHM_V = KVBLK * 128 * 2, SHM_K = KVBLK * 128 * 2;
#define KSWZ(row, colB) ((row) * 256 + ((colB) ^ (((row) & 7) << 4)))
#define SBAR() __builtin_amdgcn_sched_barrier(0)
__device__ __forceinline__ int crow(int r, int hi) { return (r & 3) + 8 * (r >> 2) + 4 * hi; }
__device__ __forceinline__ void partialSM(f32x16& p0, f32x16& p1, float& m_reg, float& mn, float& alpha) {
    constexpr float THR2 = THR * 1.4426950408889634f;
    float mx0 = fmaxf(p0[0], p0[1]), mx1 = fmaxf(p0[2], p0[3]), mx2 = fmaxf(p1[0], p1[1]), mx3 = fmaxf(p1[2], p1[3]);
#pragma unroll
    for (int r = 4; r < 16; r += 2) { mx0 = fmaxf(mx0, p0[r]); mx1 = fmaxf(mx1, p0[r + 1]); mx2 = fmaxf(mx2, p1[r]); mx3 = fmaxf(mx3, p1[r + 1]); }
    float pmax = fmaxf(fmaxf(mx0, mx1), fmaxf(mx2, mx3));
    { auto rr = __builtin_amdgcn_permlane32_swap(__float_as_uint(pmax), __float_as_uint(pmax), false, false);
      pmax = fmaxf(__uint_as_float(rr[0]), __uint_as_float(rr[1])); }
    alpha = 1.f; mn = m_reg;
    if (__builtin_expect(!__all(pmax <= THR2), 0)) {
        const float d = fmaxf(pmax, 0.f);
        alpha = __builtin_amdgcn_exp2f(-d); m_reg += d; mn = m_reg;
#pragma unroll
        for (int r = 0; r < 16; ++r) { p0[r] -= d; p1[r] -= d; }
    }
#pragma unroll
    for (int r = 0; r < 16; ++r) p0[r] = __builtin_amdgcn_exp2f(p0[r]);
}
__device__ __forceinline__ void finishSM(f32x16& p0, f32x16& p1, float alpha, float& l_reg, bf16x8& pa0, bf16x8& pa1, bf16x8& pa2, bf16x8& pa3) {
#pragma unroll
    for (int r = 0; r < 16; ++r) p1[r] = __builtin_amdgcn_exp2f(p1[r]);
    float ps = 0;
#pragma unroll
    for (int r = 0; r < 16; ++r) ps += p0[r];
#pragma unroll
    for (int r = 0; r < 16; ++r) ps += p1[r];
    { auto rr = __builtin_amdgcn_permlane32_swap(__float_as_uint(ps), __float_as_uint(ps), false, false);
      ps = __uint_as_float(rr[0]) + __uint_as_float(rr[1]); }
    l_reg = l_reg * alpha + ps;
#define PK4(P, BASE, OUT) do { unsigned a0 = cvt_pk_bf16(P[BASE + 0], P[BASE + 1]), a1 = cvt_pk_bf16(P[BASE + 2], P[BASE + 3]);   \
    unsigned b0 = cvt_pk_bf16(P[BASE + 4], P[BASE + 5]), b1 = cvt_pk_bf16(P[BASE + 6], P[BASE + 7]);                              \
    auto r0 = __builtin_amdgcn_permlane32_swap(a0, b0, false, false); auto r1 = __builtin_amdgcn_permlane32_swap(a1, b1, false, false); \
    u32x4 w = {r0[0], r1[0], r0[1], r1[1]}; OUT = *reinterpret_cast<bf16x8*>(&w); } while (0)
    PK4(p0, 0, pa0); PK4(p0, 8, pa1); PK4(p1, 0, pa2); PK4(p1, 8, pa3);
#undef PK4
}
__device__ __forceinline__ void qkt(f32x16& p0, f32x16& p1, const char* Ks, const bf16x8* qr, int r32, int hi, int map) {
    p0 = f32x16{}; p1 = f32x16{};
#pragma unroll
    for (int d0 = 0; d0 < 4; ++d0) { const int cb = (map * 64 + d0 * 16 + hi * 8) * 2;
        const bf16x8 b0 = *reinterpret_cast<const bf16x8*>(Ks + KSWZ(r32, cb));
        const bf16x8 b1 = *reinterpret_cast<const bf16x8*>(Ks + KSWZ(32 + r32, cb));
        p0 = __builtin_amdgcn_mfma_f32_32x32x16_bf16(b0, qr[d0], p0, 0, 0, 0);
        p1 = __builtin_amdgcn_mfma_f32_32x32x16_bf16(b1, qr[d0], p1, 0, 0, 0); }
}
__device__ __forceinline__ void qktL(f32x16& p0, f32x16& p1, const LAS char* Ks, const bf16x8* qr, int r32, int hi, int map, const float negm) {
#pragma unroll
    for (int r = 0; r < 16; ++r) { p0[r] = negm; p1[r] = negm; }
#pragma unroll
    for (int d0 = 0; d0 < 4; ++d0) { const int cb = (map * 64 + d0 * 16 + hi * 8) * 2;
        const bf16x8 b0 = *reinterpret_cast<const LAS bf16x8*>(Ks + KSWZ(r32, cb));
        const bf16x8 b1 = *reinterpret_cast<const LAS bf16x8*>(Ks + KSWZ(32 + r32, cb));
        p0 = __builtin_amdgcn_mfma_f32_32x32x16_bf16(b0, qr[d0], p0, 0, 0, 0);
        p1 = __builtin_amdgcn_mfma_f32_32x32x16_bf16(b1, qr[d0], p1, 0, 0, 0); }
}
__device__ __forceinline__ int v_st(int k, int c) { const int kk = (k & ~0xC) | ((k & 4) << 1) | ((k & 8) >> 1); return ((kk >> 3) * 4 + (c >> 5)) * 512 + ((kk & 7) * 32 + (c & 31)) * 2; }
__device__ __forceinline__ int v_rd_base(int lane) { return ((lane & 3) << 3) | (((lane >> 2) & 3) << 6) | (((lane >> 4) & 1) << 5) | (((lane >> 5) & 1) << 8); }
constexpr int v_rd_off(int d0, int ks, int half) { return d0 * 512 + ks * 4096 + half * 2048; }
template <int OFF> __device__ __forceinline__ s16x4 tr_read(int vb) {
    s16x4 r; asm volatile("ds_read_b64_tr_b16 %0, %1 offset:%2" : "=&v"(r) : "v"(vb), "i"(OFF) : "memory"); return r;
}
struct VFrag { s16x4 l0, h0, l1, h1, l2, h2, l3, h3; };
template <int D0> __device__ __forceinline__ void v_issue(VFrag& f, int vb) {
    f.l0 = tr_read<v_rd_off(D0, 0, 0)>(vb); f.h0 = tr_read<v_rd_off(D0, 0, 1)>(vb); f.l1 = tr_read<v_rd_off(D0, 1, 0)>(vb); f.h1 = tr_read<v_rd_off(D0, 1, 1)>(vb);
    f.l2 = tr_read<v_rd_off(D0, 2, 0)>(vb); f.h2 = tr_read<v_rd_off(D0, 2, 1)>(vb); f.l3 = tr_read<v_rd_off(D0, 3, 0)>(vb); f.h3 = tr_read<v_rd_off(D0, 3, 1)>(vb);
}
__device__ __forceinline__ void v_mma(f32x16& od, const VFrag& f, bf16x8 pa0, bf16x8 pa1, bf16x8 pa2, bf16x8 pa3) {
#define PK(L, H) (bf16x8){L[0], L[1], L[2], L[3], H[0], H[1], H[2], H[3]}
    od = __builtin_amdgcn_mfma_f32_32x32x16_bf16(pa0, PK(f.l0, f.h0), od, 0, 0, 0);
    od = __builtin_amdgcn_mfma_f32_32x32x16_bf16(pa1, PK(f.l1, f.h1), od, 0, 0, 0);
    od = __builtin_amdgcn_mfma_f32_32x32x16_bf16(pa2, PK(f.l2, f.h2), od, 0, 0, 0);
    od = __builtin_amdgcn_mfma_f32_32x32x16_bf16(pa3, PK(f.l3, f.h3), od, 0, 0, 0);
#undef PK
}
__device__ __forceinline__ void pv_d0(f32x16* o, int vb, bf16x8 pa0, bf16x8 pa1, bf16x8 pa2, bf16x8 pa3) {
    VFrag fa, fb;
    v_issue<0>(fa, vb);
    v_issue<1>(fb, vb); asm volatile("s_waitcnt lgkmcnt(8)" ::: "memory"); SBAR(); v_mma(o[0], fa, pa0, pa1, pa2, pa3); SBAR();
    v_issue<2>(fa, vb); asm volatile("s_waitcnt lgkmcnt(8)" ::: "memory"); SBAR(); v_mma(o[1], fb, pa0, pa1, pa2, pa3); SBAR();
    v_issue<3>(fb, vb); asm volatile("s_waitcnt lgkmcnt(8)" ::: "memory"); SBAR(); v_mma(o[2], fa, pa0, pa1, pa2, pa3); SBAR();
    asm volatile("s_waitcnt lgkmcnt(0)" ::: "memory"); SBAR(); v_mma(o[3], fb, pa0, pa1, pa2, pa3);
}

__device__ __forceinline__ void attn_unit(const bf16_t* __restrict__ Qb, const bf16_t* __restrict__ Kh, const bf16_t* __restrict__ Vh, bf16_t* __restrict__ Ob,
                                          const int seq, const float lam, const float* __restrict__ gs, char* lds) {
    int tid = threadIdx.x; asm volatile("" : "+v"(tid));
    const int wid = __builtin_amdgcn_readfirstlane(tid >> 6), lane = tid & 63, r32 = lane & 31, hi = lane >> 5, map = wid >> 2, wq = wid & 3;
    LAS char* const L = (LAS char*)(uintptr_t)(unsigned)(uintptr_t)lds;
    constexpr int KRING = 0, VRING = 3 * 16384, SCR = 6 * 16384;
    float* ws = (float*)(lds + SCR) + wid * 64; float* li_l = ws; float* al_l = ws + 32;
    float m_reg = 0.f, l_reg = 0; f32x16 o[4] = {}; bf16x8 qr[4];
    const bf16_t* Qw = Qb + (long)(wq * 32 + r32) * LDQ + map * 64 + hi * 8;
#pragma unroll
    for (int d0 = 0; d0 < 4; ++d0) qr[d0] = *reinterpret_cast<const bf16x8*>(Qw + d0 * 16);
    unsigned kOff[2], vOff[2];
#pragma unroll
    for (int jj = 0; jj < 2; ++jj) { const int g = (wid * 2 + jj) * 64 + lane;
        { const int row = g >> 4, c = (g & 15) ^ (row & 7); kOff[jj] = (unsigned)(row * 512 + 8 * c); }
        { const int st = g >> 5, within = (g & 31) * 16, kk = (st >> 2) * 8 + (within >> 6), c = (st & 3) * 32 + ((within & 63) >> 1), k = (kk & ~0xC) | ((kk & 4) << 1) | ((kk & 8) >> 1); vOff[jj] = (unsigned)(k * 512 + c); } }
    const int vbase = (int)(uintptr_t)lds + VRING + v_rd_base(lane);
#define DMA_K(slot, key0) do { const bf16_t* kb_ = Kh + (size_t)(key0) * 512; asm volatile("" : "+s"(kb_)); _Pragma("unroll") for (int jj_ = 0; jj_ < 2; ++jj_) \
        __builtin_amdgcn_global_load_lds((const unsigned*)(kb_ + kOff[jj_]), (LAS unsigned*)(L + KRING + (slot) * 16384 + (wid * 2 + jj_) * 1024), 16, 0, 0); } while (0)
#define DMA_V(slot, key0) do { const bf16_t* vb_ = Vh + (size_t)(key0) * 512; asm volatile("" : "+s"(vb_)); _Pragma("unroll") for (int jj_ = 0; jj_ < 2; ++jj_) \
        __builtin_amdgcn_global_load_lds((const unsigned*)(vb_ + vOff[jj_]), (LAS unsigned*)(L + VRING + (slot) * 16384 + (wid * 2 + jj_) * 1024), 16, 0, 0); } while (0)
#define WAITBAR(n) do { asm volatile("s_waitcnt vmcnt(" #n ")" ::: "memory"); __builtin_amdgcn_s_barrier(); asm volatile("" ::: "memory"); } while (0)
#define RESC(a) do { if (__any((a) < 1.f)) { if (hi == 0) al_l[r32] = (a); asm volatile("s_waitcnt lgkmcnt(0)" ::: "memory"); \
    _Pragma("unroll") for (int d = 0; d < 4; ++d) _Pragma("unroll") for (int r = 0; r < 16; ++r) o[d][r] *= al_l[crow(r, hi)]; } } while (0)
    f32x16 pA0, pA1, pB0, pB1; float mnA, mnB, alA, alB; bf16x8 pa0, pa1, pa2, pa3; const int NT = seq / KVBLK;
    int ks = 0, vs = 0;
#define NEXT3(x) ((x) == 2 ? 0 : (x) + 1)
#define PREV3(x) ((x) == 0 ? 2 : (x) - 1)
    DMA_K(0, 0); DMA_K(1, KVBLK); DMA_V(0, 0);
    WAITBAR(4);
    DMA_K(2, 2 * KVBLK); DMA_V(1, KVBLK);
    qktL(pA0, pA1, L + KRING, qr, r32, hi, map, -m_reg); partialSM(pA0, pA1, m_reg, mnA, alA);
    ks = 1; vs = 0;
    for (int j = 1; j + 1 < NT; j += 2) {
        WAITBAR(4);
        if (j + 2 < NT) DMA_K(PREV3(ks), (j + 2) * KVBLK);
        DMA_V(PREV3(vs), (j + 1) * KVBLK);
        SBAR(); qktL(pB0, pB1, L + KRING + ks * 16384, qr, r32, hi, map, -m_reg);
        finishSM(pA0, pA1, alA, l_reg, pa0, pa1, pa2, pa3); SBAR();
        pv_d0(o, vbase + vs * 16384, pa0, pa1, pa2, pa3); partialSM(pB0, pB1, m_reg, mnB, alB);
        RESC(alB);
        ks = NEXT3(ks); vs = NEXT3(vs);
        if (j + 2 < NT) WAITBAR(4); else WAITBAR(2);
        if (j + 3 < NT) DMA_K(PREV3(ks), (j + 3) * KVBLK);
        if (j + 2 < NT) DMA_V(PREV3(vs), (j + 2) * KVBLK);
        SBAR(); qktL(pA0, pA1, L + KRING + ks * 16384, qr, r32, hi, map, -m_reg);
        finishSM(pB0, pB1, alB, l_reg, pa0, pa1, pa2, pa3); SBAR();
        pv_d0(o, vbase + vs * 16384, pa0, pa1, pa2, pa3); partialSM(pA0, pA1, m_reg, mnA, alA);
        RESC(alA);
        ks = NEXT3(ks); vs = NEXT3(vs);
    }
    WAITBAR(2);
    SBAR(); qktL(pB0, pB1, L + KRING + ks * 16384, qr, r32, hi, map, -m_reg);
    finishSM(pA0, pA1, alA, l_reg, pa0, pa1, pa2, pa3); SBAR();
    pv_d0(o, vbase + vs * 16384, pa0, pa1, pa2, pa3); partialSM(pB0, pB1, m_reg, mnB, alB);
    RESC(alB);
    vs = NEXT3(vs);
    WAITBAR(0);
    finishSM(pB0, pB1, alB, l_reg, pa0, pa1, pa2, pa3); SBAR();
    pv_d0(o, vbase + vs * 16384, pa0, pa1, pa2, pa3);
    if (hi == 0) li_l[r32] = l_reg; asm volatile("s_waitcnt lgkmcnt(0)" ::: "memory");
    float rli[16];
#pragma unroll
    for (int r = 0; r < 16; ++r) rli[r] = 1.0f / li_l[crow(r, hi)];
#pragma unroll
    for (int d0 = 0; d0 < 4; ++d0)
#pragma unroll
        for (int r = 0; r < 16; ++r) o[d0][r] *= rli[r];
    __syncthreads();
    float* X = (float*)lds + wq * (32 * 128);
    if (map == 1) {
#pragma unroll
        for (int d0 = 0; d0 < 4; ++d0)
#pragma unroll
            for (int r = 0; r < 16; ++r) X[crow(r, hi) * 128 + d0 * 32 + r32] = o[d0][r];
    }
    __syncthreads();
    if (map == 0) {
#pragma unroll
        for (int d0 = 0; d0 < 4; ++d0)
#pragma unroll
            for (int r = 0; r < 16; ++r) o[d0][r] -= lam * X[crow(r, hi) * 128 + d0 * 32 + r32];
        float g4[4];
#pragma unroll
        for (int d0 = 0; d0 < 4; ++d0) g4[d0] = gs[d0 * 32 + r32];
#pragma unroll
        for (int r = 0; r < 16; ++r) {
            float ss = o[0][r] * o[0][r] + o[1][r] * o[1][r] + o[2][r] * o[2][r] + o[3][r] * o[3][r];
            ss += __shfl_xor(ss, 1); ss += __shfl_xor(ss, 2); ss += __shfl_xor(ss, 4); ss += __shfl_xor(ss, 8); ss += __shfl_xor(ss, 16);
            const float rstd = 1.0f / sqrtf(ss * (1.0f / 128.0f) + EPS);
            bf16_t* op = Ob + (long)(wq * 32 + crow(r, hi)) * 512 + r32;
#pragma unroll
            for (int d0 = 0; d0 < 4; ++d0) op[d0 * 32] = (bf16_t)(cvt_pk_bf16(o[d0][r] * rstd * g4[d0], 0.f) & 0xffffu);
        }
    }
    __syncthreads();
#undef DMA_K
#undef DMA_V
#undef WAITBAR
#undef RESC
#undef NEXT3
#undef PREV3
}
#undef KSWZ
}

struct Args { const float* in[28]; float* out; unsigned char* ws; int ph_lo, ph_hi; };

struct Frame {
    LAS unsigned char* lds; volatile LAS unsigned* MISC;
    int c, G;
    float* out; unsigned char* ws;
};
template <int I> __device__ __forceinline__ const float* inp() {
    unsigned long long p;
    asm volatile("s_load_dwordx2 %0, %1, %2\n\ts_waitcnt lgkmcnt(0)" : "=s"(p) : "s"(__builtin_amdgcn_kernarg_segment_ptr()), "n"(I * 8));
    return (const float*)(const GAS float*)p;
}
enum { I_X = 0, I_C, I_CTX, I_CCTX, I_WMOD, I_BMOD, I_GPREMIX, I_GPOSTMIX, I_GPREFFN, I_GPOSTFFN, I_WIN, I_LQ1, I_LK1, I_LQ2, I_LK2, I_GSUB, I_CONVW, I_POOLW, I_POOLS,
       I_WBR, I_WOUT, I_FG, I_FU, I_FD, I_RW, I_MG, I_MU, I_MD };

__device__ __forceinline__ int rowmap_f(int kind, int off, int n) {
    if (kind == 0) return n + off;
    if (kind == 2) return ((n >> 7) << 8) + off + (n & 127);
    if (n < 1024) { const int ch = n >> 6, o = n & 63, a = o >> 5, hh = (o >> 4) & 1, f = o & 15; return ch * 64 + a * 32 + 8 * (f >> 2) + 4 * hh + (f & 3); }
    if (n >= 2048 && n < 3072) { const int x = n - 2048, isx = x >> 9, chn = x & 511; return 2048 + ((chn >> 7) << 8) + isx * 128 + (chn & 127); }
    return n;
}
__device__ __forceinline__ void tr_item(const float* __restrict__ W, int N, int k0, int n0, bf16_t* __restrict__ WT, int ldt, int kc0, int kind, int off, LAS float* scr, int lane) {
    float tv[32];
#pragma unroll
    for (int i = 0; i < 32; ++i) tv[i] = W[(size_t)(k0 + 2 * i + (lane >> 5)) * N + n0 + (lane & 31)];
#pragma unroll
    for (int i = 0; i < 32; ++i) scr[(2 * i + (lane >> 5)) * 33 + (lane & 31)] = tv[i];
    LDS_WAIT(); asm volatile("" ::: "memory");
    const int c = lane & 7;
#pragma unroll
    for (int j = 0; j < 4; ++j) { const int n = (lane >> 3) + 8 * j; const LAS float* s = scr + (8 * c) * 33 + n;
        u32x4 o; o.x = cvt_pk_bf16(s[0 * 33], s[1 * 33]); o.y = cvt_pk_bf16(s[2 * 33], s[3 * 33]); o.z = cvt_pk_bf16(s[4 * 33], s[5 * 33]); o.w = cvt_pk_bf16(s[6 * 33], s[7 * 33]);
        *(u32x4*)(WT + (size_t)rowmap_f(kind, off, n0 + n) * ldt + kc0 + k0 + 8 * c) = o; }
    LDS_WAIT(); asm volatile("" ::: "memory");
}
__device__ __forceinline__ void tr_item8(const float* __restrict__ W, int N, int k0, int n0, unsigned char* __restrict__ WT, int ldt, int kind, int off, LAS float* scr, int lane) {
    float tv[32];
#pragma unroll
    for (int i = 0; i < 32; ++i) tv[i] = W[(size_t)(k0 + 2 * i + (lane >> 5)) * N + n0 + (lane & 31)];
#pragma unroll
    for (int i = 0; i < 32; ++i) scr[(2 * i + (lane >> 5)) * 33 + (lane & 31)] = tv[i];
    LDS_WAIT(); asm volatile("" ::: "memory");
    const int c = lane & 3;
#pragma unroll
    for (int j = 0; j < 2; ++j) { const int n = (lane >> 2) + 16 * j; const LAS float* sp = scr + (16 * c) * 33 + n;
        u32x4 o;
        constexpr float SW = pg8::I8_SW;
        o.x = pg8::pk_i8x4(sp[0 * 33] * SW, sp[1 * 33] * SW, sp[2 * 33] * SW, sp[3 * 33] * SW); o.y = pg8::pk_i8x4(sp[4 * 33] * SW, sp[5 * 33] * SW, sp[6 * 33] * SW, sp[7 * 33] * SW);
        o.z = pg8::pk_i8x4(sp[8 * 33] * SW, sp[9 * 33] * SW, sp[10 * 33] * SW, sp[11 * 33] * SW); o.w = pg8::pk_i8x4(sp[12 * 33] * SW, sp[13 * 33] * SW, sp[14 * 33] * SW, sp[15 * 33] * SW);
        *(u32x4*)(WT + (size_t)rowmap_f(kind, off, n0 + n) * ldt + k0 + 16 * c) = o; }
    LDS_WAIT(); asm volatile("" ::: "memory");
}
__device__ __forceinline__ void tr_job(int r, const float* W, int K, int N, bf16_t* WT, int ldt, int kc0, int kind, int off, LAS float* scr, int lane) {
    const int nblk = N / 32, kb = r / nblk, nb = r % nblk;
    tr_item(W, N, 64 * kb, 32 * nb, WT, ldt, kc0, kind, off, scr, lane);
}

__device__ __forceinline__ void p_conv(Frame& F) {
    int tid = threadIdx.x; asm volatile("" : "+v"(tid)); const int lane = tid & 63, wave = __builtin_amdgcn_readfirstlane(tid >> 6); (void)lane; (void)wave;

    unsigned char* ws = F.ws;
    LAS float* scr = (LAS float*)(F.lds + wave * 16384);
    const int gw = F.c * NWAVES + wave, NGW = F.G * NWAVES;
    constexpr int I_IN = 8 * 208, I_BR = 8 * 32, I_O = 16 * 32, I_GU = 8 * 88, I_D = 44 * 32;
    constexpr int NIT = 2 * I_IN + 4 * I_BR + 2 * I_O + 2 * I_GU + I_D;
    for (int it = gw; it < NIT; it += NGW) {
        int r = it;
        if (r < 2 * I_IN) { const int l = r / I_IN; r -= l * I_IN; const int nblk = INW / 32, nb = r % nblk, j = r / nblk;
            tr_item8(inp<I_WIN>() + (size_t)l * DM * INW, INW, 128 * j, 32 * nb, ws + (l ? WS_WIN1 : WS_WIN0), DM, 1, 0, scr, lane);
            tr_item8(inp<I_WIN>() + (size_t)l * DM * INW, INW, 128 * j + 64, 32 * nb, ws + (l ? WS_WIN1 : WS_WIN0), DM, 1, 0, scr, lane); continue; } r -= 2 * I_IN;
        if (r < 4 * I_BR) { const int l = r / (2 * I_BR), j = (r / I_BR) & 1; r %= I_BR; tr_job(r, inp<I_WBR>() + (size_t)(l * 3 + j) * 512 * DM, 512, DM, (bf16_t*)(ws + (l ? WS_WM1 : WS_WM0)), 1536, 512 * j, 0, 0, scr, lane); continue; } r -= 4 * I_BR;
        if (r < 2 * I_O) { const int l = r / I_O; r -= l * I_O; tr_job(r, inp<I_WOUT>() + (size_t)l * DM * DM, DM, DM, (bf16_t*)(ws + (l ? WS_WO1 : WS_WO0)), DM, 0, 0, 0, scr, lane); continue; } r -= 2 * I_O;
        if (r < 2 * I_GU) { const int up = r / I_GU; r -= up * I_GU; const int nblk = DFF / 32, nb = r % nblk, j = r / nblk; const float* W = up ? inp<I_FU>() : inp<I_FG>();
            tr_item8(W, DFF, 128 * j, 32 * nb, ws + WS_WGU, DM, 2, up * 128, scr, lane);
            tr_item8(W, DFF, 128 * j + 64, 32 * nb, ws + WS_WGU, DM, 2, up * 128, scr, lane); continue; } r -= 2 * I_GU;
        tr_job(r, inp<I_FD>(), DFF, DM, (bf16_t*)(ws + WS_WD), DFF, 0, 0, 0, scr, lane);
    }
    __syncthreads();
    {
        LAS float* pwT = (LAS float*)F.lds;
        for (int item = F.c; item < 2 * 8 * 16; item += F.G) {
            const int nb = item & 15, blk = (item >> 4) & 7, l = item >> 7, g = blk >> 1;
            const float* pw = inp<I_POOLW>() + ((size_t)l * 512 + blk * 64) * 128;
#pragma unroll
            for (int i = 0; i < 16; ++i) { const int idx = tid + 512 * i; pwT[(idx & 127) * 65 + (idx >> 7)] = pw[idx]; }
            __syncthreads();
            const float* ps = inp<I_POOLS>() + l * 512 + g * 128;
            const int n0 = nb * 64 + wave * 8;
            const float* wb = inp<I_WBR>() + ((size_t)(l * 3 + 2) * 512 + g * 128) * DM + n0;
            float fa[8];
#pragma unroll
            for (int j = 0; j < 8; ++j) fa[j] = 0.f;
#pragma unroll 4
            for (int c = 0; c < 128; ++c) { const float p = pwT[c * 65 + lane] * ps[c]; const f32x4 w0 = *(const f32x4*)(wb + (size_t)c * DM), w1 = *(const f32x4*)(wb + (size_t)c * DM + 4);
                fa[0] += p * w0[0]; fa[1] += p * w0[1]; fa[2] += p * w0[2]; fa[3] += p * w0[3]; fa[4] += p * w1[0]; fa[5] += p * w1[1]; fa[6] += p * w1[2]; fa[7] += p * w1[3]; }
            bf16_t* dst = (bf16_t*)(ws + (l ? WS_WM1 : WS_WM0)) + (size_t)n0 * 1536 + 1024 + blk * 64 + lane;
#pragma unroll
            for (int j = 0; j < 8; ++j) dst[(size_t)j * 1536] = (bf16_t)(cvt_pk_bf16(fa[j], 0.f) & 0xffffu);
            __syncthreads();
        }
    }
    __syncthreads();
    {
        LAS float* sl = (LAS float*)F.lds;
        LAS float* part = (LAS float*)(F.lds + 40960);
        for (int i = tid; i < 9 * 1024; i += NTHREADS) { const float v = (i < 8192) ? inp<I_C>()[i] : inp<I_CCTX>()[i - 8192]; sl[i] = silu_f(v); }
        __syncthreads();
        for (int item = F.c; item < 192; item += F.G) {
            const int l = item / 96, j0 = (item % 96) * 64;
            const float* wm = inp<I_WMOD>() + (size_t)l * DM * 6144 + j0 + lane;
            float a[9];
#pragma unroll
            for (int r = 0; r < 9; ++r) a[r] = 0.f;
            const int kb = wave * 128;
#pragma unroll 8
            for (int k = 0; k < 128; ++k) { const float w = wm[(size_t)(kb + k) * 6144];
#pragma unroll
                for (int r = 0; r < 9; ++r) a[r] += sl[r * 1024 + kb + k] * w; }
#pragma unroll
            for (int r = 0; r < 9; ++r) part[(wave * 9 + r) * 64 + lane] = a[r];
            __syncthreads();
            for (int i = tid; i < 576; i += NTHREADS) { const int r = i >> 6, ln = i & 63; float s = inp<I_BMOD>()[l * 6144 + j0 + ln];
#pragma unroll
                for (int w = 0; w < 8; ++w) s += part[(w * 9 + r) * 64 + ln];
                ((float*)(ws + WS_MOD))[(size_t)(l * 9 + r) * 6144 + j0 + ln] = s; }
            __syncthreads();
        }
    }
    if (F.c == 0) {
        float* rc = (float*)(ws + WS_ROPE); float* rs = rc + 1024;
        for (int i = tid; i < 1024; i += NTHREADS) { const int pos = i >> 4, f = i & 15; const float inv = powf(10000.0f, -(float)f / 16.0f); const float ang = (float)pos * inv; rc[i] = cosf(ang); rs[i] = sinf(ang); }
        if (wave == 0) {
            for (int l = 0; l < 2; ++l) {
                const float a = wave_sum(inp<I_LQ1>()[l * 64 + lane] * inp<I_LK1>()[l * 64 + lane]);
                const float b = wave_sum(inp<I_LQ2>()[l * 64 + lane] * inp<I_LK2>()[l * 64 + lane]);
                const float lam_init = l ? 0.35550907f : 0.2f;
                if (lane == 0) ((float*)(ws + WS_LAM))[l] = expf(a) - expf(b) + lam_init;
            }
        }
    }
}
__device__ __forceinline__ void p_conv_moe(Frame& F, const int wg0) {
    int tid = threadIdx.x; asm volatile("" : "+v"(tid)); const int lane = tid & 63, wave = __builtin_amdgcn_readfirstlane(tid >> 6); (void)lane; (void)wave;
    if (F.c < wg0) return;
    LAS float* scr = (LAS float*)(F.lds + wave * 16384);
    const int gw = (F.c - wg0) * NWAVES + wave, NGW = (F.G - wg0) * NWAVES;
    constexpr int I_GU = 8 * 88, I_D = 44 * 32, PER_E = 2 * I_GU + I_D;
    for (int it = gw; it < NE * PER_E; it += NGW) {
        const int e = it / PER_E; int r = it % PER_E;
        unsigned char* we = (unsigned char*)F.out + (size_t)e * MOE_ESTRIDE;
        if (r < 2 * I_GU) { const int up = r / I_GU; r -= up * I_GU; const int nblk = DFF / 32, nb = r % nblk, j = r / nblk; const float* W = (up ? inp<I_MU>() : inp<I_MG>()) + (size_t)e * DM * DFF;
            tr_item8(W, DFF, 128 * j, 32 * nb, we, DM, 2, up * 128, scr, lane);
            tr_item8(W, DFF, 128 * j + 64, 32 * nb, we, DM, 2, up * 128, scr, lane); }
        else { r -= 2 * I_GU; tr_job(r, inp<I_MD>() + (size_t)e * DFF * DM, DFF, DM, (bf16_t*)(we + MOE_WD_OFF), DFF, 0, 0, 0, scr, lane); }
    }
}

__device__ __forceinline__ void ld_row_f32(const float* p, int lane, f32x4 (&v)[4]) {
#pragma unroll
    for (int j = 0; j < 4; ++j) v[j] = *(const f32x4*)(p + 4 * lane + 256 * j);
}
__device__ __forceinline__ void ld_row_bf16(const bf16_t* p, int lane, f32x4 (&v)[4]) {
#pragma unroll
    for (int j = 0; j < 4; ++j) { const u32x2 w = *(const u32x2*)(p + 4 * lane + 256 * j); v[j] = (f32x4){bf_lo(w.x), bf_hi(w.x), bf_lo(w.y), bf_hi(w.y)}; }
}
__device__ __forceinline__ void st_row_bf16(bf16_t* p, int lane, const f32x4 (&v)[4]) {
#pragma unroll
    for (int j = 0; j < 4; ++j) { u32x2 w; w.x = cvt_pk_bf16(v[j][0], v[j][1]); w.y = cvt_pk_bf16(v[j][2], v[j][3]); *(u32x2*)(p + 4 * lane + 256 * j) = w; }
}
__device__ __forceinline__ void st_row_f32(float* p, int lane, const f32x4 (&v)[4]) {
#pragma unroll
    for (int j = 0; j < 4; ++j) *(f32x4*)(p + 4 * lane + 256 * j) = v[j];
}
__device__ __forceinline__ float row_ss(const f32x4 (&v)[4]) {
    float s = 0.f;
#pragma unroll
    for (int j = 0; j < 4; ++j) s += (v[j][0] * v[j][0] + v[j][1] * v[j][1]) + (v[j][2] * v[j][2] + v[j][3] * v[j][3]);
    return wave_sum(s);
}
__device__ __forceinline__ void norm_mod_store(const f32x4 (&x)[4], const float* g, const float* sh, const float* sc, bf16_t* dst, int lane, f32x4 (&h)[4]) {
    const float rstd = 1.0f / sqrtf(row_ss(x) * (1.0f / DM) + EPS);
    f32x4 gv[4], sv[4], cv[4]; ld_row_f32(g, lane, gv); ld_row_f32(sh, lane, sv); ld_row_f32(sc, lane, cv);
#pragma unroll
    for (int j = 0; j < 4; ++j) h[j] = (x[j] * rstd * gv[j]) * (1.0f + cv[j]) + sv[j];
    st_row_bf16(dst, lane, h);
}
__device__ __forceinline__ void ld_row_raw(const bf16_t* p, int lane, u32x2 (&w)[4]) {
#pragma unroll
    for (int j = 0; j < 4; ++j) w[j] = *(const u32x2*)(p + 4 * lane + 256 * j);
}
__device__ __forceinline__ void cvt_row(const u32x2 (&w)[4], f32x4 (&v)[4]) {
#pragma unroll
    for (int j = 0; j < 4; ++j) v[j] = (f32x4){bf_lo(w[j].x), bf_hi(w[j].x), bf_lo(w[j].y), bf_hi(w[j].y)};
}
__device__ __forceinline__ void norm_mod_store_v(const f32x4 (&x)[4], const f32x4 (&gv)[4], const f32x4 (&sv)[4], const f32x4 (&cv)[4], bf16_t* dst, int lane, f32x4 (&h)[4]) {
    const float rstd = 1.0f / sqrtf(row_ss(x) * (1.0f / DM) + EPS);
#pragma unroll
    for (int j = 0; j < 4; ++j) h[j] = (x[j] * rstd * gv[j]) * (1.0f + cv[j]) + sv[j];
    st_row_bf16(dst, lane, h);
}
__device__ __forceinline__ void norm_mod_store8(const f32x4 (&x)[4], const f32x4 (&gv)[4], const f32x4 (&sv)[4], const f32x4 (&cv)[4], unsigned char* dst, float* rs, int lane, f32x4 (&h)[4]) {
    const float rstd = 1.0f / sqrtf(row_ss(x) * (1.0f / DM) + EPS);
    float am = 0.f;
#pragma unroll
    for (int j = 0; j < 4; ++j) { h[j] = (x[j] * rstd * gv[j]) * (1.0f + cv[j]) + sv[j]; am = fmaxf(am, fmaxf(fmaxf(fabsf(h[j][0]), fabsf(h[j][1])), fmaxf(fabsf(h[j][2]), fabsf(h[j][3])))); }
#pragma unroll
    for (int o = 1; o < 64; o <<= 1) am = fmaxf(am, __shfl_xor(am, o));
    am = fmaxf(am, 1e-20f);
    const float inv = 127.0f / am;
#pragma unroll
    for (int j = 0; j < 4; ++j) *(unsigned*)(dst + 4 * lane + 256 * j) = pg8::pk_i8x4(h[j][0] * inv, h[j][1] * inv, h[j][2] * inv, h[j][3] * inv);
    if (lane == 0) st_agent(rs, am * (1.0f / 127.0f));
}
__device__ __forceinline__ void norm_mod_store8f(const f32x4 (&x)[4], const f32x4 (&gv)[4], const f32x4 (&sv)[4], const f32x4 (&cv)[4], unsigned char* dst, float* rs, int lane, f32x4 (&h)[4]) {
    const float rstd = 1.0f / sqrtf(row_ss(x) * (1.0f / DM) + EPS);
#pragma unroll
    for (int j = 0; j < 4; ++j) { h[j] = (x[j] * rstd * gv[j]) * (1.0f + cv[j]) + sv[j]; *(unsigned*)(dst + 4 * lane + 256 * j) = pg8::pk_i8x4(h[j][0] * 24.f, h[j][1] * 24.f, h[j][2] * 24.f, h[j][3] * 24.f); }
}
__device__ __forceinline__ void pair_range(int gw, int NGW, int npairs, int& pb, int& pe) { pb = (int)(((long)gw * npairs) / NGW); pe = (int)(((long)(gw + 1) * npairs) / NGW); }
__device__ __forceinline__ void p_h0(Frame& F) {
    int tid = threadIdx.x; asm volatile("" : "+v"(tid)); const int lane = tid & 63, wave = __builtin_amdgcn_readfirstlane(tid >> 6);
    int pb, pe; pair_range(F.c * NWAVES + wave, F.G * NWAVES, MT / 2, pb, pe);
    f32x4 gv[4], sv[4], cv[4]; int mrc = -1;
    for (int p = pb; p < pe; ++p) {
        const int row = 2 * p; const bool lat = row < ML; const int mr = lat ? (row >> 12) : 8;
        const float* xin = lat ? inp<I_X>() + (size_t)row * DM : inp<I_CTX>() + (size_t)(row - ML) * DM;
        f32x4 xa[4], xb[4], h[4];
        ld_row_f32(xin, lane, xa); ld_row_f32(xin + DM, lane, xb);
        if (mr != mrc) { const float* mod = (const float*)(F.ws + WS_MOD) + (size_t)mr * 6144; ld_row_f32(inp<I_GPREMIX>(), lane, gv); ld_row_f32(mod, lane, sv); ld_row_f32(mod + 1024, lane, cv); mrc = mr; }
        norm_mod_store8f(xa, gv, sv, cv, F.ws + WS_H + (size_t)row * DM, (float*)(F.ws + WS_RSH) + row, lane, h);
        norm_mod_store8f(xb, gv, sv, cv, F.ws + WS_H + (size_t)(row + 1) * DM, (float*)(F.ws + WS_RSH) + row + 1, lane, h);
    }
}
__device__ __forceinline__ void route_row(Frame& F, const f32x4 (&h)[4], LAS float* rwt, volatile LAS int* cntl, int row, int lane) {
    float lg[8];
#pragma unroll
    for (int e = 0; e < 8; ++e) { float s = 0.f;
#pragma unroll
        for (int j = 0; j < 4; ++j) { const f32x4 w = *(const LAS f32x4*)(rwt + e * 1024 + 4 * lane + 256 * j); s += (h[j][0] * w[0] + h[j][1] * w[1]) + (h[j][2] * w[2] + h[j][3] * w[3]); }
        lg[e] = wave_sum(s); }
    int e0 = 0; float v0 = lg[0];
#pragma unroll
    for (int e = 1; e < 8; ++e) if (lg[e] > v0) { v0 = lg[e]; e0 = e; }
    int e1 = -1; float v1 = -3.0e38f;
#pragma unroll
    for (int e = 0; e < 8; ++e) if (e != e0 && lg[e] > v1) { v1 = lg[e]; e1 = e; }
    const float ex = expf(v1 - v0), p0 = 1.0f / (1.0f + ex), p1 = ex * p0;
    if (lane == 0) { ((int*)(F.ws + WS_TKE))[row * 2] = e0; ((int*)(F.ws + WS_TKE))[row * 2 + 1] = e1;
        ((float*)(F.ws + WS_TKP))[row * 2] = p0; ((float*)(F.ws + WS_TKP))[row * 2 + 1] = p1;
        __hip_atomic_fetch_add((LAS int*)&cntl[e0], 1, __ATOMIC_RELAXED, __HIP_MEMORY_SCOPE_WORKGROUP); __hip_atomic_fetch_add((LAS int*)&cntl[e1], 1, __ATOMIC_RELAXED, __HIP_MEMORY_SCOPE_WORKGROUP); }
}
__device__ __forceinline__ void nr1_pair(Frame& F, const int l, const int row, const int lane, LAS float* rwt, volatile LAS int* cntl,
                                         const f32x4 (&g)[4], const f32x4 (&gv)[4], const f32x4 (&sv)[4], const f32x4 (&cv)[4]) {
    const bf16_t* MIX = (const bf16_t*)(F.ws + WS_MIX);
    const bool lat = row < ML;
    const float* xin = lat ? inp<I_X>() + (size_t)row * DM : inp<I_CTX>() + (size_t)(row - ML) * DM;
    bf16_t* x16 = (bf16_t*)(F.ws + WS_X16) + (size_t)row * DM;
    float* yo = (float*)(F.ws + WS_Y) + (size_t)(row - ML) * DM;
    u32x2 wa[4], wb[4]; f32x4 xa[4], xb[4], mx[4], h[4];
    ld_row_raw(MIX + (size_t)row * DM, lane, wa); ld_row_raw(MIX + (size_t)(row + 1) * DM, lane, wb);
    if (l == 0) { ld_row_f32(xin, lane, xa); ld_row_f32(xin + DM, lane, xb); }
    else { u32x2 ra[4], rb[4]; ld_row_raw(x16, lane, ra); ld_row_raw(x16 + DM, lane, rb); cvt_row(ra, xa); cvt_row(rb, xb); }
    cvt_row(wa, mx);
    { const float rstd = 1.0f / sqrtf(row_ss(mx) * (1.0f / DM) + EPS);
#pragma unroll
      for (int j = 0; j < 4; ++j) xa[j] = xa[j] + g[j] * (mx[j] * rstd); }
    if (lat) st_row_bf16(x16, lane, xa); else st_row_f32(yo, lane, xa);
    norm_mod_store8(xa, gv, sv, cv, F.ws + (l ? WS_H : WS_H2_0) + (size_t)row * DM, (float*)(F.ws + (l ? WS_RSH : WS_RSH2)) + row, lane, h);
    if (l == 1) route_row(F, h, rwt, cntl, row, lane);
    cvt_row(wb, mx);
    { const float rstd = 1.0f / sqrtf(row_ss(mx) * (1.0f / DM) + EPS);
#pragma unroll
      for (int j = 0; j < 4; ++j) xb[j] = xb[j] + g[j] * (mx[j] * rstd); }
    if (lat) st_row_bf16(x16 + DM, lane, xb); else st_row_f32(yo + DM, lane, xb);
    norm_mod_store8(xb, gv, sv, cv, F.ws + (l ? WS_H : WS_H2_0) + (size_t)(row + 1) * DM, (float*)(F.ws + (l ? WS_RSH : WS_RSH2)) + row + 1, lane, h);
    if (l == 1) route_row(F, h, rwt, cntl, row + 1, lane);
}
__device__ __forceinline__ void nr1_vectors(Frame& F, const int l, const int mr, const int lane, f32x4 (&g)[4], f32x4 (&gv)[4], f32x4 (&sv)[4], f32x4 (&cv)[4]) {
    const float* mod = (const float*)(F.ws + WS_MOD) + (size_t)(l * 9 + mr) * 6144; f32x4 gt[4];
    ld_row_f32(inp<I_GPOSTMIX>() + l * DM, lane, g); ld_row_f32(mod + 2048, lane, gt);
    ld_row_f32(inp<I_GPREFFN>() + l * DM, lane, gv); ld_row_f32(mod + 3072, lane, sv); ld_row_f32(mod + 4096, lane, cv);
#pragma unroll
    for (int j = 0; j < 4; ++j) g[j] = g[j] * gt[j];
}
__device__ __forceinline__ void p_nr1(Frame& F, const int l) {
    int tid = threadIdx.x; asm volatile("" : "+v"(tid)); const int lane = tid & 63, wave = __builtin_amdgcn_readfirstlane(tid >> 6);
    LAS float* rwt = (LAS float*)F.lds;
    volatile LAS int* cntl = (volatile LAS int*)(F.MISC + 16);
    f32x4 g[4], gv[4], sv[4], cv[4];
    if (l == 1) {
        for (int i = tid; i < 8192; i += NTHREADS) rwt[(i & 7) * 1024 + (i >> 3)] = inp<I_RW>()[i];
        for (int ch = F.c; ch < ML / 128; ch += F.G) {
            if (tid < 8) cntl[tid] = 0;
            __syncthreads();
            nr1_vectors(F, 1, (ch * 128) >> 12, lane, g, gv, sv, cv);
            for (int i = 0; i < 16; i += 2) nr1_pair(F, 1, ch * 128 + wave * 16 + i, lane, rwt, cntl, g, gv, sv, cv);
            __syncthreads();
            if (tid < 8) st_agent((int*)(F.ws + WS_CNT) + ch * 8 + tid, cntl[tid]);
            __syncthreads();
        }
    } else {
        int pb, pe; pair_range(F.c * NWAVES + wave, F.G * NWAVES, MT / 2, pb, pe); int mrc = -1;
        for (int p = pb; p < pe; ++p) { const int row = 2 * p, mr = row < ML ? (row >> 12) : 8;
            if (mr != mrc) { nr1_vectors(F, 0, mr, lane, g, gv, sv, cv); mrc = mr; }
            nr1_pair(F, 0, row, lane, rwt, cntl, g, gv, sv, cv); }
    }
}
__device__ __forceinline__ void p_nr2(Frame& F, const int l) {
    int tid = threadIdx.x; asm volatile("" : "+v"(tid)); const int lane = tid & 63, wave = __builtin_amdgcn_readfirstlane(tid >> 6);
    const int nrows = l ? ML : MT;
    int pb, pe; pair_range(F.c * NWAVES + wave, F.G * NWAVES, nrows / 2, pb, pe); int mrc = -1;
    f32x4 g[4], gv[4], sv[4], cv[4];
    for (int p = pb; p < pe; ++p) {
        const int row = 2 * p; const bool lat = row < ML; const int mr = lat ? (row >> 12) : 8;
        bf16_t* x16 = (bf16_t*)(F.ws + WS_X16) + (size_t)row * DM; float* yp = (float*)(F.ws + WS_Y) + (size_t)(row - ML) * DM;
        f32x4 fa[4], fb[4], xa[4], xb[4], h[4];
        if (lat) { u32x2 ra[4], rb[4]; ld_row_raw(x16, lane, ra); ld_row_raw(x16 + DM, lane, rb); cvt_row(ra, xa); cvt_row(rb, xb); } else { ld_row_f32(yp, lane, xa); ld_row_f32(yp + DM, lane, xb); }
        if (l == 0) { u32x2 wa[4], wb[4];
            ld_row_raw((const bf16_t*)(F.ws + WS_F_0) + (size_t)row * DM, lane, wa); ld_row_raw((const bf16_t*)(F.ws + WS_F_0) + (size_t)(row + 1) * DM, lane, wb);
            cvt_row(wa, fa); cvt_row(wb, fb);
        } else {
            const int* ps = (const int*)(F.ws + WS_PSLOT) + row * 2; const float* pp = (const float*)(F.ws + WS_TKP) + row * 2;
            const int s0 = ps[0], s1 = ps[1], s2 = ps[2], s3 = ps[3]; const float p0 = pp[0], p1 = pp[1], p2 = pp[2], p3 = pp[3];
            u32x2 w0[4], w1[4], w2[4], w3[4]; const bf16_t* OP = (const bf16_t*)(F.ws + WS_OUTP);
            ld_row_raw(OP + (size_t)s0 * DM, lane, w0); ld_row_raw(OP + (size_t)s1 * DM, lane, w1); ld_row_raw(OP + (size_t)s2 * DM, lane, w2); ld_row_raw(OP + (size_t)s3 * DM, lane, w3);
            f32x4 a[4], b[4]; cvt_row(w0, a); cvt_row(w1, b);
#pragma unroll
            for (int j = 0; j < 4; ++j) fa[j] = p0 * a[j] + p1 * b[j];
            cvt_row(w2, a); cvt_row(w3, b);
#pragma unroll
            for (int j = 0; j < 4; ++j) fb[j] = p2 * a[j] + p3 * b[j];
        }
        if (mr != mrc) { const float* mod = (const float*)(F.ws + WS_MOD) + (size_t)(l * 9 + mr) * 6144; f32x4 gt[4];
            ld_row_f32(inp<I_GPOSTFFN>() + l * DM, lane, g); ld_row_f32(mod + 5120, lane, gt);
#pragma unroll
            for (int j = 0; j < 4; ++j) g[j] = g[j] * gt[j];
            if (l == 0) { const float* mod1 = (const float*)(F.ws + WS_MOD) + (size_t)(9 + mr) * 6144; ld_row_f32(inp<I_GPREMIX>() + DM, lane, gv); ld_row_f32(mod1, lane, sv); ld_row_f32(mod1 + 1024, lane, cv); }
            mrc = mr; }
        { const float rstd = 1.0f / sqrtf(row_ss(fa) * (1.0f / DM) + EPS);
#pragma unroll
          for (int j = 0; j < 4; ++j) xa[j] = xa[j] + g[j] * (fa[j] * rstd); }
        if (!lat) st_row_f32(yp, lane, xa); else if (l == 0) st_row_bf16(x16, lane, xa); else st_row_f32(F.out + (size_t)row * DM, lane, xa);
        if (l == 0) norm_mod_store8f(xa, gv, sv, cv, F.ws + WS_H + (size_t)row * DM, (float*)(F.ws + WS_RSH) + row, lane, h);
        { const float rstd = 1.0f / sqrtf(row_ss(fb) * (1.0f / DM) + EPS);
#pragma unroll
          for (int j = 0; j < 4; ++j) xb[j] = xb[j] + g[j] * (fb[j] * rstd); }
        if (!lat) st_row_f32(yp + DM, lane, xb); else if (l == 0) st_row_bf16(x16 + DM, lane, xb); else st_row_f32(F.out + (size_t)(row + 1) * DM, lane, xb);
        if (l == 0) norm_mod_store8f(xb, gv, sv, cv, F.ws + WS_H + (size_t)(row + 1) * DM, (float*)(F.ws + WS_RSH) + row + 1, lane, h);
    }
}
__device__ __forceinline__ void p_convpool(Frame& F, const int l) {
    int tid = threadIdx.x; asm volatile("" : "+v"(tid)); const int lane = tid & 63, wave = __builtin_amdgcn_readfirstlane(tid >> 6); (void)lane; (void)wave;

    const int gw = F.c * NWAVES + wave, NGW = F.G * NWAVES;
    const bf16_t* CB = (const bf16_t*)(F.ws + WS_CB); const bf16_t* U = (const bf16_t*)(F.ws + WS_U); const bf16_t* PIN = (const bf16_t*)(F.ws + WS_PIN); bf16_t* P = (bf16_t*)(F.ws + WS_P);
    bf16_t* CO = l ? (bf16_t*)(F.ws + WS_CONVO1) : (bf16_t*)F.out;
    const int nrows = l ? ML : MT; const int c0 = 8 * lane;
    const float* cw = inp<I_CONVW>() + l * 1536 + c0;
    const f32x4 w0a = *(const f32x4*)(cw), w0b = *(const f32x4*)(cw + 4), w1a = *(const f32x4*)(cw + 512), w1b = *(const f32x4*)(cw + 516), w2a = *(const f32x4*)(cw + 1024), w2b = *(const f32x4*)(cw + 1028);
    const int g = lane >> 4, hw = 1 << g;
    for (int row = gw; row < nrows; row += NGW) {
        const bool lat = row < ML; const int t = lat ? (row & 4095) : ((row - ML) & 255), L = lat ? SEQ : CTXL;
        const u32x4 z4 = {0u, 0u, 0u, 0u};
        const u32x4 uc = *(const u32x4*)(U + (size_t)row * 512 + c0);
        const u32x4 up = t > 0 ? *(const u32x4*)(U + (size_t)(row - 1) * 512 + c0) : z4;
        const u32x4 un = t < L - 1 ? *(const u32x4*)(U + (size_t)(row + 1) * 512 + c0) : z4;
        const u32x4 cb = *(const u32x4*)(CB + (size_t)row * 512 + c0);
        f32x4 o0, o1;
#define CV(w, lo_) ((lo_) ? bf_lo(w) : bf_hi(w))
        o0[0] = bf_lo(cb.x) * (w0a[0] * bf_lo(up.x) + w1a[0] * bf_lo(uc.x) + w2a[0] * bf_lo(un.x)); o0[1] = bf_hi(cb.x) * (w0a[1] * bf_hi(up.x) + w1a[1] * bf_hi(uc.x) + w2a[1] * bf_hi(un.x));
        o0[2] = bf_lo(cb.y) * (w0a[2] * bf_lo(up.y) + w1a[2] * bf_lo(uc.y) + w2a[2] * bf_lo(un.y)); o0[3] = bf_hi(cb.y) * (w0a[3] * bf_hi(up.y) + w1a[3] * bf_hi(uc.y) + w2a[3] * bf_hi(un.y));
        o1[0] = bf_lo(cb.z) * (w0b[0] * bf_lo(up.z) + w1b[0] * bf_lo(uc.z) + w2b[0] * bf_lo(un.z)); o1[1] = bf_hi(cb.z) * (w0b[1] * bf_hi(up.z) + w1b[1] * bf_hi(uc.z) + w2b[1] * bf_hi(un.z));
        o1[2] = bf_lo(cb.w) * (w0b[2] * bf_lo(up.w) + w1b[2] * bf_lo(uc.w) + w2b[2] * bf_lo(un.w)); o1[3] = bf_hi(cb.w) * (w0b[3] * bf_hi(up.w) + w1b[3] * bf_hi(uc.w) + w2b[3] * bf_hi(un.w));
#undef CV
        *(u32x4*)(CO + (size_t)row * 512 + c0) = pg8::pack8(o0, o1);
        const int lo = (t - hw) > 0 ? (t - hw) : 0, hi = (t + hw) < L ? (t + hw) : L;
        const bf16_t* pb = PIN + (size_t)(row - t) * 512 + c0;
        u32x4 wv[16];
#pragma unroll
        for (int j = 0; j < 16; ++j) { const int tt = t - hw + j; const bool ok = (j < 2 * hw) && tt >= 0 && tt < L; wv[j] = ok ? *(const u32x4*)(pb + (size_t)tt * 512) : z4; }
        const u32x4 w = *(const u32x4*)(pb + (size_t)t * 512);
        f32x4 s0 = {0.f, 0.f, 0.f, 0.f}, s1 = {0.f, 0.f, 0.f, 0.f};
#pragma unroll
        for (int j = 0; j < 16; ++j) { s0 += (f32x4){bf_lo(wv[j].x), bf_hi(wv[j].x), bf_lo(wv[j].y), bf_hi(wv[j].y)}; s1 += (f32x4){bf_lo(wv[j].z), bf_hi(wv[j].z), bf_lo(wv[j].w), bf_hi(wv[j].w)}; }
        const float inv = 1.0f / (float)(hi - lo);
        s0 = s0 * inv - (f32x4){bf_lo(w.x), bf_hi(w.x), bf_lo(w.y), bf_hi(w.y)}; s1 = s1 * inv - (f32x4){bf_lo(w.z), bf_hi(w.z), bf_lo(w.w), bf_hi(w.w)};
        *(u32x4*)(P + (size_t)row * 512 + c0) = pg8::pack8(s0, s1);
    }
}
__device__ __forceinline__ void p_attn(Frame& F, const int l, char* lds) {
    int tid = threadIdx.x; asm volatile("" : "+v"(tid)); const int lane = tid & 63, wave = __builtin_amdgcn_readfirstlane(tid >> 6); (void)lane; (void)wave;

    const bf16_t* Q = (const bf16_t*)(F.ws + WS_Q); const bf16_t* Kb = (const bf16_t*)(F.ws + WS_K); const bf16_t* Vb = (const bf16_t*)(F.ws + WS_V); bf16_t* AO = (bf16_t*)(F.ws + WS_AO);
    const float lam = ((const float*)(F.ws + WS_LAM))[l];
    const float lam_init = l ? 0.35550907f : 0.2f;
    LAS float* gsl = (LAS float*)(F.lds + 100352);
    if (tid < 128) gsl[tid] = inp<I_GSUB>()[l * 128 + tid] * (1.0f - lam_init);
    __syncthreads();
    const float* gs = (const float*)(lds + 100352);
    for (int uid = F.c; uid < 1024; uid += F.G) {
        const int xcd = uid & 7, j = uid >> 3, qb = j & 31, bh = (j >> 5) * 8 + xcd, b = bh >> 2, h = bh & 3;
        const size_t qrow = (size_t)b * SEQ + qb * 128, krow = (size_t)b * TALL;
        att::attn_unit(Q + qrow * 512 + h * 128, Kb + krow * 512 + h * 128, Vb + krow * 512 + h * 128, AO + qrow * 512 + h * 128, TALL, lam, gs, lds);
    }
    if (l == 0) {
        for (int uid = F.c; uid < 64; uid += F.G) {
            const int b = uid >> 3, h = (uid >> 1) & 3, qb = uid & 1;
            const size_t qrow = (size_t)ML + b * CTXL + qb * 128, krow = (size_t)b * TALL;
            att::attn_unit(Q + qrow * 512 + h * 128, Kb + krow * 512 + h * 128, Vb + krow * 512 + h * 128, AO + qrow * 512 + h * 128, CTXL, lam, gs, lds);
        }
    }
}
__device__ __forceinline__ void p_route(Frame& F) {
    int tid = threadIdx.x; asm volatile("" : "+v"(tid)); const int lane = tid & 63, wave = __builtin_amdgcn_readfirstlane(tid >> 6); (void)lane; (void)wave;

    volatile LAS int* sm = (volatile LAS int*)F.lds;
    const int* CNT = (const int*)(F.ws + WS_CNT); const int* TKE = (const int*)(F.ws + WS_TKE);
    int* ROWMAP = (int*)(F.ws + WS_ROWMAP); int* PSLOT = (int*)(F.ws + WS_PSLOT); int* PEXP = (int*)(F.ws + WS_PEXP);
    for (int ch = F.c; ch < 256; ch += F.G) {
        if (tid < 64) sm[tid] = 0;
        __syncthreads();
        { const int e = tid & 7, part = tid >> 3; int lt = 0, lp = 0;
#pragma unroll
          for (int q = 0; q < 4; ++q) { const int cq = part * 4 + q; const int v = ld_agent(CNT + cq * 8 + e); lt += v; if (cq < ch) lp += v; }
          __hip_atomic_fetch_add((LAS int*)&sm[e], lt, __ATOMIC_RELAXED, __HIP_MEMORY_SCOPE_WORKGROUP); __hip_atomic_fetch_add((LAS int*)&sm[8 + e], lp, __ATOMIC_RELAXED, __HIP_MEMORY_SCOPE_WORKGROUP); }
        __syncthreads();
        if (tid == 0) { int b = 0; for (int e = 0; e < 8; ++e) { sm[16 + e] = b; b += (sm[e] + 255) & ~255; } sm[24] = b; }
        __syncthreads();
        int e = 0, rk = 0, tok = 0, k = 0;
        if (tid < 256) {
            const int tl = tid >> 1; k = tid & 1; tok = ch * 128 + tl; e = TKE[tok * 2 + k];
            const unsigned long long lt_mask = (1ull << lane) - 1ull;
#pragma unroll
            for (int ee = 0; ee < 8; ++ee) { const unsigned long long m = __ballot(e == ee); if (e == ee) rk = __popcll(m & lt_mask); if (lane == 0) sm[32 + wave * 8 + ee] = __popcll(m); }
        }
        __syncthreads();
        if (tid < 256) {
            int r = sm[16 + e] + sm[8 + e] + rk;
            for (int w = 0; w < wave; ++w) r += sm[32 + w * 8 + e];
            st_agent(ROWMAP + r, tok); PSLOT[tok * 2 + k] = r; st_agent((float*)(F.ws + WS_RSS) + r, ld_agent((const float*)(F.ws + WS_RSH) + tok));
        }
        if (ch < 8) { const int st = sm[16 + ch] + sm[ch], en = sm[16 + ch + 1]; for (int s = st + tid; s < en; s += NTHREADS) { st_agent(ROWMAP + s, 0); st_agent((float*)(F.ws + WS_RSS) + s, 0.f); } }
        if (ch == 8) { for (int p = tid; p < 272; p += NTHREADS) { int ee = 0;
#pragma unroll
                for (int q = 1; q < 8; ++q) if (p * 256 >= sm[16 + q]) ee = q;
                PEXP[p] = ee; }
            if (tid == 0) PEXP[272] = sm[24] >> 8; }
        __syncthreads();
    }
}

constexpr int NPH = 21;
__global__ void __launch_bounds__(NTHREADS, 2) mk_fwd(Args args) {
    extern __shared__ __attribute__((aligned(16))) unsigned char lds[];
    Frame F;
    F.lds = (LAS unsigned char*)lds; F.MISC = (volatile LAS unsigned*)(F.lds + MISC_OFF);
    const int tid0 = threadIdx.x;
    F.G = gridDim.x; F.c = blockIdx.x;
    F.out = args.out; F.ws = args.ws;
    unsigned char* ws = args.ws;
    for (int u = tid0; u < (LDS_BYTES - RING_BYTES) / 4; u += NTHREADS) ((LAS unsigned*)(F.lds + RING_BYTES))[u] = 0u;
    __syncthreads();
    const int lo = args.ph_lo, hi = args.ph_hi;
    XcdBarrier bar; bar.bar = (unsigned*)(ws + WS_CTL) + CW_BAR; bar.x = 0; bar.st = nullptr;
    if (hi - lo > 1) bar = xcd_barrier_post((unsigned*)(ws + WS_CTL) + CW_BAR, F.MISC + 8);
    int ph = 0;
#ifndef MK_SITES
#define MK_SITES 0xffffu
#endif
#ifndef MK_REPEAT
#define MK_REPEAT (-1)
#endif
#define PH_BEGIN(site) if (((MK_SITES >> (site)) & 1u) && ph >= lo && ph < hi) { for (int rep_ = 0; rep_ < ((site) == MK_REPEAT ? 2 : 1); ++rep_) { if (rep_) __syncthreads();
#define PH_END   } if (ph + 1 < hi) xcd_barrier(bar); } ++ph;

    PH_BEGIN(0) p_conv(F); PH_END
    PH_BEGIN(1) p_h0(F); PH_END

    for (int l = 0; l < 2; ++l) {
        PH_BEGIN(2)
            pg8::SchedG S; S.o.init(l ? 128 : 136, 26, F.G, F.c); S.A = (const char*)(ws + WS_H); S.B = (const char*)(ws + (l ? WS_WIN1 : WS_WIN0));
            S.astep = 256 * DM; S.bstep = 256 * DM; S.nx = l ? 32 : 0;
            pg8::EpiZ<true> E{ws};
            pg8::gemm_phase<pg8::EpiZ<true>, pg8::SchedG, false, false, true>(F.lds, DM / 2, DM / 2, DM / 2, S, E, 0, 0, nullptr);
        PH_END
        PH_BEGIN(3)
            if (rep_ == 0) p_convpool(F, l);
            p_attn(F, l, (char*)lds);
        PH_END
        PH_BEGIN(4)
            pg8::SchedG S; S.o.init(l ? 128 : 136, 4, F.G, F.c); S.A = (const char*)(ws + WS_AO); S.B = (const char*)(ws + (l ? WS_WM1 : WS_WM0));
            S.astep = 256 * 512 * 2; S.bstep = 256 * 1536 * 2; S.nx = 0;
            pg8::EpiMerge E{(bf16_t*)(ws + WS_MERGED), (const unsigned char*)(ws + WS_GT)};
            const long seg1 = l ? (long)WS_CONVO1 - (long)WS_AO : (long)((const char*)F.out - (const char*)(ws + WS_AO));
            pg8::gemm_phase<pg8::EpiMerge, pg8::SchedG, true, false>(F.lds, 1536, 512, 1536, S, E, seg1, (long)WS_P - (long)WS_AO, nullptr);
        PH_END
        PH_BEGIN(5)
            pg8::SchedG S; S.o.init(l ? 128 : 136, 4, F.G, F.c); S.A = (const char*)(ws + WS_MERGED); S.B = (const char*)(ws + (l ? WS_WO1 : WS_WO0));
            S.astep = 256 * DM * 2; S.bstep = 256 * DM * 2; S.nx = 0;
            pg8::EpiPlain E{(bf16_t*)(ws + WS_MIX), DM, 1.0f};
            pg8::gemm_phase<pg8::EpiPlain, pg8::SchedG, false, false>(F.lds, DM, DM, DM, S, E, 0, 0, nullptr);
        PH_END
        PH_BEGIN(6) p_nr1(F, l); PH_END
        if (l == 0) {
            PH_BEGIN(7)
                pg8::SchedG S; S.o.init(136, 22, F.G, F.c); S.A = (const char*)(ws + WS_H2_0); S.B = (const char*)(ws + WS_WGU);
                S.astep = 256 * DM; S.bstep = 256 * DM; S.nx = 0;
                pg8::EpiGluI8 E{(bf16_t*)(ws + WS_ACT0), (const float*)(ws + WS_RSH2)};
                pg8::gemm_phase<pg8::EpiGluI8, pg8::SchedG, false, false, true>(F.lds, DM / 2, DM / 2, DM / 2, S, E, 0, 0, nullptr);
            PH_END
            PH_BEGIN(8)
                pg8::SchedG S; S.o.init(136, 4, F.G, F.c); S.A = (const char*)(ws + WS_ACT0); S.B = (const char*)(ws + WS_WD);
                S.astep = 256 * DFF * 2; S.bstep = 256 * DFF * 2; S.nx = 0;
                pg8::EpiPlain E{(bf16_t*)(ws + WS_F_0), DM, 1.0f};
                pg8::gemm_phase<pg8::EpiPlain, pg8::SchedG, false, false>(F.lds, DFF, DFF, DFF, S, E, 0, 0, nullptr);
                __syncthreads(); p_conv_moe(F, 32);
            PH_END
        } else {
            PH_BEGIN(9) p_route(F); PH_END
            const int np_all = __builtin_amdgcn_readfirstlane(((const int*)(ws + WS_PEXP))[272]);
            int ntail = np_all - 256; ntail = ntail < 0 ? 0 : (ntail > 8 ? 8 : ntail);
            for (int ci = 0; ci < 2; ++ci) {
                int npc = np_all - 128 * ci; npc = npc < 0 ? 0 : (npc > 128 ? 128 : npc);
                const bool tailwg = ci == 1 && F.c < 32 && (F.c & 7) < ntail;
                PH_BEGIN(10)
                    if (tailwg) {
                        const int pt = F.c & 7, pn = F.c >> 3, e = __builtin_amdgcn_readfirstlane(((const int*)(ws + WS_PEXP))[256 + pt]);
                        pg8::SchedOne S; S.has = true; S.u0.pm = 256 + pt; S.u0.pn = pn; S.u0.aux = 256 + pt;
                        S.u0.A = (const char*)(ws + WS_ACT1) + (size_t)(128 + pt) * (256 * DFF * 2); S.u0.B = (const char*)F.out + MOE_WD_OFF + (size_t)e * MOE_ESTRIDE + (size_t)pn * (256 * DFF * 2);
                        pg8::EpiPlain E{(bf16_t*)(ws + WS_OUTP), DM, 1.0f};
                        pg8::gemm_phase<pg8::EpiPlain, pg8::SchedOne, false, false>(F.lds, DFF, DFF, DFF, S, E, 0, 0, nullptr);
                        __syncthreads();
                    }
                    const int nM = npc + (ci == 0 ? ntail : 0);
                    if (nM > 0) {
                        pg8::SchedMoe S; S.o.init(nM, 22, F.G, F.c); S.p0 = 128 * ci; S.nmain = npc; S.ptail = 256; S.pexp = (const int*)(ws + WS_PEXP); S.A = (const char*)(ws + WS_H); S.astep = 0;
                        S.B = (const char*)F.out; S.estride = (int)MOE_ESTRIDE; S.bstep = 256 * DM;
                        S.own = 0x7fffffff; S.extraL = -1;
                        if (ci == 1 && ntail > 0 && F.G == 256 && nM == 128) {
                            const int ntw = 4 * ntail;
                            if (tailwg) S.own = 7;
                            else { S.own = 11; const int k = F.c - 32; if (k >= 0 && k < 4 * ntw) { const int t = k % ntw; S.extraL = (long)(7 + k / ntw) * 256 + ((t % ntail) + 8 * (t / ntail)); } }
                        }
                        pg8::EpiGluI8 E{(bf16_t*)(ws + WS_ACT1), (const float*)(ws + WS_RSS)};
                        pg8::gemm_phase<pg8::EpiGluI8, pg8::SchedMoe, false, true, true>(F.lds, DM / 2, DM / 2, DM / 2, S, E, 0, 0, (const int*)(ws + WS_ROWMAP));
                    }
                PH_END
                PH_BEGIN(11)
                    if (npc > 0) {
                        pg8::SchedMoe S; S.o.init(npc, 4, F.G, F.c); S.p0 = 128 * ci; S.nmain = npc; S.ptail = 256; S.pexp = (const int*)(ws + WS_PEXP); S.A = (const char*)(ws + WS_ACT1); S.astep = 256 * DFF * 2;
                        S.B = (const char*)F.out + MOE_WD_OFF; S.estride = (int)MOE_ESTRIDE; S.bstep = 256 * DFF * 2;
                        S.own = 0x7fffffff; S.extraL = -1;
                        pg8::EpiPlain E{(bf16_t*)(ws + WS_OUTP) + (size_t)ci * 32768 * DM, DM, 1.0f};
                        pg8::gemm_phase<pg8::EpiPlain, pg8::SchedMoe, false, false>(F.lds, DFF, DFF, DFF, S, E, 0, 0, nullptr);
                    }
                PH_END
            }
        }
        PH_BEGIN(12) p_nr2(F, l); PH_END
    }
#undef PH_BEGIN
#undef PH_END
}

extern "C" void kernel_launch(void* const* d_in, const int* in_sizes, int n_in, void* d_out, int out_size, void* d_ws, size_t ws_size, hipStream_t stream) {
    static int grid = 0;
    if (grid == 0) {
        if (n_in != 28 || in_sizes[0] != ML * DM || out_size != ML * DM || ws_size < WS_END) {
            fprintf(stderr, "kernel_launch: shape/workspace mismatch (n_in %d, ws %zu, need %zu); nothing launched\n", n_in, ws_size, (size_t)WS_END); grid = -1; return; }
        if (hipFuncSetAttribute((const void*)mk_fwd, hipFuncAttributeMaxDynamicSharedMemorySize, LDS_BYTES) != hipSuccess) { fprintf(stderr, "kernel_launch: hipFuncSetAttribute failed\n"); grid = -1; return; }
        int dev = 0, cus = 0, per_cu = 0;
        if (hipGetDevice(&dev) != hipSuccess || hipDeviceGetAttribute(&cus, hipDeviceAttributeMultiprocessorCount, dev) != hipSuccess) { grid = -1; return; }
        if (hipOccupancyMaxActiveBlocksPerMultiprocessor(&per_cu, (const void*)mk_fwd, NTHREADS, LDS_BYTES) != hipSuccess || per_cu < 1)
            fprintf(stderr, "kernel_launch: occupancy query reports %d\n", per_cu);
        (void)hipGetLastError();
        grid = cus;
        if (grid != 256) fprintf(stderr, "kernel_launch: %d CUs (built for 256)\n", grid);
    }
    if (grid < 0) return;
    if (hipMemsetAsync((char*)d_ws + WS_CTL, 0, CTL_ZERO_BYTES, stream) != hipSuccess) return;
    Args a{};
    for (int i = 0; i < 28; ++i) a.in[i] = (const float*)d_in[i];
    a.out = (float*)d_out; a.ws = (unsigned char*)d_ws;
#if MK_MULTI
    for (int p = 0; p < NPH; ++p) { a.ph_lo = p; a.ph_hi = p + 1; hipLaunchKernelGGL(mk_fwd, dim3(grid), dim3(NTHREADS), LDS_BYTES, stream, a); }
#else
    a.ph_lo = 0; a.ph_hi = NPH;
    hipLaunchKernelGGL(mk_fwd, dim3(grid), dim3(NTHREADS), LDS_BYTES, stream, a);
#endif
    const hipError_t le = hipPeekAtLastError();
    if (le != hipSuccess) fprintf(stderr, "kernel_launch: launch failed: %s\n", hipGetErrorName(le));
}
```

```cpp
#include <hip/hip_runtime.h>
#include <cstdio>
#include <cstdint>

#ifndef MK_MULTI
#define MK_MULTI 0
#endif

#define LAS __attribute__((address_space(3)))
#define GAS __attribute__((address_space(1)))
typedef unsigned short bf16_t;
typedef short bf16x8 __attribute__((ext_vector_type(8)));
typedef short s16x4 __attribute__((ext_vector_type(4)));
typedef float f32x2 __attribute__((ext_vector_type(2)));
typedef float f32x4 __attribute__((ext_vector_type(4)));
typedef float f32x16 __attribute__((ext_vector_type(16)));
typedef unsigned u32x2 __attribute__((ext_vector_type(2)));
typedef unsigned u32x4 __attribute__((ext_vector_type(4)));

constexpr int NB = 8, SEQ = 4096, DM = 1024, CTXL = 256;
constexpr int ML = NB * SEQ, MC = NB * CTXL, MT = ML + MC, TALL = SEQ + CTXL;
constexpr int INW = 6656, DFF = 2816, NE = 8;
constexpr float EPS = 1e-6f;
constexpr int NWAVES = 8, NTHREADS = 512;

constexpr size_t MiB = 1u << 20, HMiB = 1u << 19;
constexpr size_t WS_CTL = 0, CTL_ZERO_BYTES = 64 * 1024;
constexpr size_t WS_MOD = 1 * MiB;
constexpr size_t WS_ROPE = 1 * MiB + 512 * 1024;
constexpr size_t WS_LAM = WS_ROPE + 16384;
constexpr size_t WS_TKE = 2 * MiB;
constexpr size_t WS_TKP = 2 * MiB + 256 * 1024;
constexpr size_t WS_PSLOT = 2 * MiB + 512 * 1024;
constexpr size_t WS_ROWMAP = 2 * MiB + 768 * 1024;
constexpr size_t WS_CNT = 3 * MiB + 256 * 1024;
constexpr size_t WS_PEXP = 3 * MiB + 320 * 1024;
constexpr size_t WS_RSH = 3 * MiB + 400 * 1024;
constexpr size_t WS_RSH2 = 3 * MiB + 560 * 1024;
constexpr size_t WS_RSS = 3 * MiB + 704 * 1024;
constexpr size_t WS_Y = 4 * MiB;
constexpr size_t WS_WIN1 = 12 * MiB, WS_WM1 = 25 * MiB, WS_WO1 = 28 * MiB;
constexpr size_t WS_WIN0 = 30 * MiB, WS_WM0 = 43 * MiB, WS_WO0 = 46 * MiB, WS_WGU = 48 * MiB, WS_WD = 59 * MiB;
constexpr size_t WS_Q = 64 * MiB + HMiB, WS_K = WS_Q + 34 * MiB, WS_V = WS_K + 34 * MiB;
constexpr size_t WS_CB = WS_V + 34 * MiB, WS_U = WS_CB + 34 * MiB, WS_PIN = WS_U + 34 * MiB;
constexpr size_t WS_GT = WS_PIN + 34 * MiB;
constexpr size_t WS_H = WS_GT + 204 * MiB;
constexpr size_t WS_AO = WS_H, WS_P = WS_H + 34 * MiB;
constexpr size_t WS_END = WS_H + 68 * MiB;
constexpr size_t WS_MERGED = WS_Q;
constexpr size_t WS_MIX = WS_U;
constexpr size_t WS_H2_0 = WS_GT;
constexpr size_t WS_F_0 = WS_GT + 34 * MiB;
constexpr size_t WS_ACT0 = WS_Q;
constexpr size_t WS_WMOE = 320 * MiB;
constexpr size_t WS_X16 = 408 * MiB;
constexpr size_t MOE_ESTRIDE = 11 * MiB, MOE_WD_OFF = 5 * MiB + HMiB;
constexpr size_t WS_CONVO1 = 30 * MiB;
constexpr size_t WS_ACT1 = 12 * MiB;
constexpr size_t WS_OUTP = 200 * MiB;
static_assert(WS_OUTP + 132 * MiB <= WS_X16 && WS_ACT1 + 187 * MiB <= WS_OUTP && WS_X16 + 64 * MiB <= WS_H && WS_F_0 + 68 * MiB <= WS_X16 && WS_GT + 102 * MiB <= WS_X16, "moe / residual map");
static_assert(WS_ACT0 + (size_t)MT * DFF * 2 <= WS_H2_0, "dense act map");

constexpr int CW_TMO = 0;
constexpr int CW_BAR = 1024;

constexpr int RING_BYTES = 131072;
constexpr int MISC_OFF = RING_BYTES + 320;
constexpr int LDS_BYTES = 147456;

#define LDS_WAIT() asm volatile("s_waitcnt lgkmcnt(0)" ::: "memory")
#define VM_WAIT() asm volatile("s_waitcnt vmcnt(0)" ::: "memory")
__device__ __forceinline__ unsigned cvt_pk_bf16(float lo, float hi) { unsigned r; asm volatile("v_cvt_pk_bf16_f32 %0, %1, %2" : "=v"(r) : "v"(lo), "v"(hi)); return r; }
__device__ __forceinline__ float bf_lo(unsigned u) { return __uint_as_float(u << 16); }
__device__ __forceinline__ float bf_hi(unsigned u) { return __uint_as_float(u & 0xffff0000u); }
__device__ __forceinline__ float wave_sum(float v) {
#pragma unroll
    for (int o = 1; o < 64; o <<= 1) v += __shfl_xor(v, o);
    return v;
}
__device__ __forceinline__ void st_agent(float* p, float v) { __hip_atomic_store(p, v, __ATOMIC_RELAXED, __HIP_MEMORY_SCOPE_AGENT); }
__device__ __forceinline__ void st_agent(int* p, int v) { __hip_atomic_store(p, v, __ATOMIC_RELAXED, __HIP_MEMORY_SCOPE_AGENT); }
__device__ __forceinline__ float ld_agent(const float* p) { return __hip_atomic_load(p, __ATOMIC_RELAXED, __HIP_MEMORY_SCOPE_AGENT); }
__device__ __forceinline__ int ld_agent(const int* p) { return __hip_atomic_load(p, __ATOMIC_RELAXED, __HIP_MEMORY_SCOPE_AGENT); }
__device__ __forceinline__ float fast_rcp(float x) { return __builtin_amdgcn_rcpf(x); }
__device__ __forceinline__ float sigmoid_c(float x) { x = fminf(fmaxf(x, -30.f), 30.f); return fast_rcp(1.f + __builtin_amdgcn_exp2f(-1.4426950408889634f * x)); }
__device__ __forceinline__ float silu_f(float x) { return x * fast_rcp(1.f + __builtin_amdgcn_exp2f(-1.4426950408889634f * x)); }

#define XB_TMO      128
#define XB_XCNT(j)  (256  + 64 * (j))
#define XB_XSUB(j)  (1280 + 64 * (j))
#define XB_XGEN(j)  (2304 + 64 * (j))
#define XB_TOP      3328
#define XB_TOPGEN   3392
#define XCD_BAR_WORDS 3456
#define XB_SPIN_CAP (1u << 20)
__device__ __forceinline__ unsigned xb_ld(unsigned* p)              { return __hip_atomic_load(p, __ATOMIC_RELAXED, __HIP_MEMORY_SCOPE_AGENT); }
__device__ __forceinline__ unsigned xb_add(unsigned* p, unsigned v) { return __hip_atomic_fetch_add(p, v, __ATOMIC_RELAXED, __HIP_MEMORY_SCOPE_AGENT); }
__device__ __forceinline__ unsigned xb_xcc_id() { return (unsigned)__builtin_amdgcn_s_getreg((3 << 11) | 20) & 0xFu; }
#define XB_SPIN(cond, bar) do { unsigned _sp = 0; while (cond) { __builtin_amdgcn_s_sleep(1); \
    if ((++_sp & 255u) == 0u) { if (xb_ld(&(bar)[XB_TMO])) break; if (_sp > XB_SPIN_CAP) { atomicAdd(&(bar)[XB_TMO], 1u); break; } } } } while (0)
struct XcdBarrier { unsigned* bar; unsigned x; volatile LAS unsigned* st; };
__device__ __forceinline__ XcdBarrier xcd_barrier_post(unsigned* bar, volatile LAS unsigned* st) {
    XcdBarrier b; b.bar = bar; b.x = xb_xcc_id(); b.st = st;
    if (threadIdx.x == 0) (void)xb_add(&bar[XB_XCNT(b.x)], 1u);
    return b;
}
__device__ __forceinline__ void xcd_barrier_complete(unsigned* bar, unsigned x, unsigned& nloc, unsigned& nx) {
    const unsigned G = gridDim.x * gridDim.y * gridDim.z;
    unsigned sum, cnt, mine, sp = 0u;
    for (;;) {
        sum = 0u; cnt = 0u; mine = 0u;
#pragma unroll
        for (unsigned j = 0; j < 16; ++j) { const unsigned c = xb_ld(&bar[XB_XCNT(j)]); sum += c; cnt += (c > 0u) ? 1u : 0u; mine = (j == x) ? c : mine; }
        if (sum == G) break;
        __builtin_amdgcn_s_sleep(1);
        if ((++sp & 255u) == 0u) { if (xb_ld(&bar[XB_TMO])) break; if (sp > XB_SPIN_CAP) { atomicAdd(&bar[XB_TMO], 1u); break; } }
    }
    nloc = mine > 0u ? mine : 1u; nx = cnt > 0u ? cnt : 1u;
}
__device__ __forceinline__ void xcd_barrier(const XcdBarrier& b) {
    asm volatile("s_waitcnt vmcnt(0)" ::: "memory");
    __syncthreads();
    if (threadIdx.x == 0) {
        unsigned* bar = b.bar;
        __builtin_amdgcn_s_waitcnt(0);
        unsigned nloc = b.st[0], nx = b.st[1];
        if (nloc == 0u) { xcd_barrier_complete(bar, b.x, nloc, nx); b.st[0] = nloc; b.st[1] = nx; }
        const unsigned old = xb_add(&bar[XB_XSUB(b.x)], 1u);
        const unsigned gen = old / nloc;
        if (old + 1u == (gen + 1u) * nloc) {
            __builtin_amdgcn_fence(__ATOMIC_RELEASE, "agent");
            asm volatile("s_waitcnt vmcnt(0)" ::: "memory");
            const unsigned og = xb_add(&bar[XB_TOP], 1u);
            const unsigned tg = og / nx;
            if (og + 1u == (tg + 1u) * nx) xb_add(&bar[XB_TOPGEN], 1u);
            else XB_SPIN(xb_ld(&bar[XB_TOPGEN]) == tg, bar);
            __builtin_amdgcn_fence(__ATOMIC_ACQUIRE, "agent");
            xb_add(&bar[XB_XGEN(b.x)], 1u);
            asm volatile("s_waitcnt vmcnt(0)" ::: "memory");
        } else {
            XB_SPIN(xb_ld(&bar[XB_XGEN(b.x)]) == gen, bar);
            __builtin_amdgcn_fence(__ATOMIC_ACQUIRE, "agent");
            asm volatile("s_waitcnt vmcnt(0)" ::: "memory");
        }
    }
    __syncthreads();
}

namespace pg8 {
constexpr int BM = 256, BK = 64, HALF = 128, HTB = HALF * BK * 2, STAGE_BYTES = 8 * HTB, NXCD = 8, WGM = 8;
__device__ __forceinline__ int lds_byte(int r, int c) { const int st = (r >> 4) * 2 + (c >> 5), rr = r & 15, cc = c & 31, ob = rr * 64 + cc * 2; return st * 1024 + (ob ^ (((ob >> 9) & 1) << 5)); }
__device__ __forceinline__ void stage_rc(int b, int& R, int& C) { const int st = b / 1024, sb = b % 1024, swz = sb ^ (((sb >> 9) & 1) << 5); R = (st >> 1) * 16 + swz / 64; C = (st & 1) * 32 + (swz % 64) / 2; }
__device__ __forceinline__ int perm32(int rho) { const int n = rho >> 4, i = rho & 15; return 8 * (i >> 2) + 4 * n + (i & 3); }

typedef int i32x4 __attribute__((ext_vector_type(4)));
typedef int i32x8 __attribute__((ext_vector_type(8)));
struct Unit { int pm, pn, aux; const char* A; const char* B; };

struct TileOrder {
    int nM, nN, nwg, G, c;
    __device__ __forceinline__ void init(int nM_, int nN_, int G_, int c_) { nM = nM_; nN = nN_; nwg = nM * nN; G = G_; c = c_; }
    __device__ __forceinline__ void tile(int L, int& pm, int& pn) const {
        int wgid = L; { const int q = nwg / NXCD, r = nwg % NXCD, xcd = wgid % NXCD, off = wgid / NXCD; wgid = (xcd < r ? xcd * (q + 1) : r * (q + 1) + (xcd - r) * q) + off; }
        const int nig = WGM * nN, gid = wgid / nig, fm = gid * WGM, gsz = (nM - fm) < WGM ? (nM - fm) : WGM;
        pm = fm + ((wgid % nig) % gsz); pn = (wgid % nig) / gsz;
    }
};

template <class Epi, class Sched, bool KSEG, bool GATHER, bool I8 = false>
__device__ __forceinline__ void gemm_phase(LAS unsigned char* lds, const int K, const int lda, const int ldb, const Sched& S, const Epi& E,
                                           const long segoff1, const long segoff2, const int* __restrict__ rowmap) {
    int tid = threadIdx.x; asm volatile("" : "+v"(tid));
    const int wid = __builtin_amdgcn_readfirstlane(tid >> 6), lane = tid & 63, wr = wid >> 2, wc = wid & 3, fr = lane & 15, fq = lane >> 4;
    const int nt = K / BK;
    int Rr[2], Cc[2];
    unsigned voffB[2], vaC[2][2], vaN[2][2];
    const size_t hstepB = (size_t)HALF * ldb * 2;
#pragma unroll
    for (int i = 0; i < 2; ++i) { stage_rc(tid * 16 + i * 8192, Rr[i], Cc[i]); const int Rb = (Rr[i] & ~31) + perm32(Rr[i] & 31);
        voffB[i] = (unsigned)(Rb * ldb + Cc[i]) * 2u;
#pragma unroll
        for (int h = 0; h < 2; ++h) { vaC[h][i] = (unsigned)((h * HALF + Rr[i]) * lda + Cc[i]) * 2u; vaN[h][i] = vaC[h][i]; } }
    const unsigned ldsw = (unsigned)wid * 1024u;
    const int aoff = lds_byte(wr * 64 + fr, fq * 8), boff = lds_byte(wc * 32 + fr, fq * 8);
#define PG8_SA(b, h) (((b) * 2 + (h)) * HTB)
#define PG8_SB(b, h) ((4 + (b) * 2 + (h)) * HTB)
#define PG8_STAGE(bufoff, gbase, voff) do { const char* gb_ = (const char*)(gbase); asm volatile("" : "+s"(gb_));     \
        _Pragma("unroll") for (int _i = 0; _i < 2; ++_i) \
        __builtin_amdgcn_global_load_lds((const unsigned*)(gb_ + (voff)[_i]), (LAS unsigned*)(lds + (bufoff) + ldsw + _i * 8192), 16, 0, 0); } while (0)
#define PG8_LDA(dst, b, h) do { _Pragma("unroll") for (int m = 0; m < 4; ++m) _Pragma("unroll") for (int k = 0; k < 2; ++k) dst[m][k] = *(const LAS bf16x8*)(lds + PG8_SA(b, h) + aoff + m * 2048 + k * 1024); } while (0)
#define PG8_LDB(dst, b, h) do { _Pragma("unroll") for (int n = 0; n < 2; ++n) _Pragma("unroll") for (int k = 0; k < 2; ++k) dst[n][k] = *(const LAS bf16x8*)(lds + PG8_SB(b, h) + boff + n * 2048 + k * 1024); } while (0)
#define PG8_MMA(ai, bj, At, Bt) do { __builtin_amdgcn_s_setprio(1); _Pragma("unroll") for (int m = 0; m < 4; ++m) _Pragma("unroll") for (int n = 0; n < 2; ++n) _Pragma("unroll") for (int k = 0; k < 2; ++k) { \
        if constexpr (I8) acc[ai][bj][m][n] = __builtin_bit_cast(f32x4, __builtin_amdgcn_mfma_i32_16x16x64_i8(__builtin_bit_cast(i32x4, Bt[n][k]), __builtin_bit_cast(i32x4, At[m][k]), __builtin_bit_cast(i32x4, acc[ai][bj][m][n]), 0, 0, 0)); \
        else acc[ai][bj][m][n] = __builtin_amdgcn_mfma_f32_16x16x32_bf16(Bt[n][k], At[m][k], acc[ai][bj][m][n], 0, 0, 0); } __builtin_amdgcn_s_setprio(0); } while (0)
#define PG8_WAIT_V(n) asm volatile("s_waitcnt vmcnt(" #n ")" ::: "memory")
#define PG8_WAIT_L(n) asm volatile("s_waitcnt lgkmcnt(" #n ")" ::: "memory")
#define PG8_BAR __builtin_amdgcn_s_barrier()
#define PG8_SCHED __builtin_amdgcn_sched_barrier(0)
#define PG8_KOFF(t) (KSEG ? ((long)(((t) >> 3) == 0 ? 0L : (((t) >> 3) == 1 ? segoff1 : segoff2)) + (long)((t) & 7) * 128L) : (long)(t) * 128L)
#define PG8_GATHER(dst, u) do { if constexpr (GATHER) { _Pragma("unroll") for (int _h = 0; _h < 2; ++_h) _Pragma("unroll") for (int _i = 0; _i < 2; ++_i) \
        dst[_h][_i] = (unsigned)(ld_agent(rowmap + (u).aux * 256 + _h * HALF + Rr[_i]) * lda + Cc[_i]) * 2u; } } while (0)
    Unit cur, nxt; int ui = 0;
    if (!S.next(0, cur)) return;
    f32x4 acc[2][2][4][2];
#pragma unroll
    for (int a = 0; a < 2; ++a)
#pragma unroll
        for (int b = 0; b < 2; ++b)
#pragma unroll
            for (int m = 0; m < 4; ++m)
#pragma unroll
                for (int n = 0; n < 2; ++n) acc[a][b][m][n] = (f32x4){0.f, 0.f, 0.f, 0.f};
    bf16x8 At[4][2], B0[2][2], B1[2][2];
    const char* cA = cur.A; const char* cB = cur.B;
    PG8_GATHER(vaC, cur);
    PG8_STAGE(PG8_SB(0, 0), cB, voffB); PG8_STAGE(PG8_SB(0, 1), cB + hstepB, voffB); PG8_STAGE(PG8_SA(0, 0), cA, vaC[0]); PG8_STAGE(PG8_SA(0, 1), cA, vaC[1]);
    if (wr == 1) PG8_BAR;
    PG8_WAIT_V(2); PG8_BAR;
    PG8_STAGE(PG8_SB(1, 0), cB + 128, voffB); PG8_STAGE(PG8_SA(1, 0), cA + PG8_KOFF(1), vaC[0]); PG8_STAGE(PG8_SB(1, 1), cB + hstepB + 128, voffB);
    PG8_WAIT_V(6); PG8_BAR;
    for (;;) {
        const bool has_next = S.next(ui + 1, nxt);
        const char* nA = has_next ? nxt.A : cA; const char* nB = has_next ? nxt.B : cB;
        if constexpr (GATHER) { if (has_next) { PG8_GATHER(vaN, nxt); } else {
#pragma unroll
            for (int h = 0; h < 2; ++h)
#pragma unroll
                for (int i = 0; i < 2; ++i) vaN[h][i] = vaC[h][i]; } }
        const int tchunk = Epi::MIDK ? 8 : nt;
        for (int t0 = 0; t0 < nt; t0 += tchunk) {
        if constexpr (Epi::MIDK) { if (t0 > 0) { PG8_SCHED; E.rescale(acc, cur, (t0 >> 3) - 1, wr, wc, fr, fq); PG8_SCHED; } }
        for (int t = t0; t < t0 + tchunk; t += 2) {
            const bool last = (t == nt - 2);
            const char* a1 = cA + PG8_KOFF(t + 1);
            const char* a2 = last ? nA : cA + PG8_KOFF(t + 2); const char* b2 = last ? nB : cB + (size_t)(t + 2) * 128;
            const char* a3 = last ? nA + PG8_KOFF(1) : cA + PG8_KOFF(t + 3); const char* b3 = b2 + 128;
            unsigned v20[2], v21[2];
#pragma unroll
            for (int i = 0; i < 2; ++i) { v20[i] = (GATHER && last) ? vaN[0][i] : vaC[0][i]; v21[i] = (GATHER && last) ? vaN[1][i] : vaC[1][i]; }
            PG8_LDB(B0, 0, 0); PG8_LDB(B1, 0, 1); PG8_SCHED; PG8_LDA(At, 0, 0); PG8_STAGE(PG8_SA(1, 1), a1, vaC[1]);
            PG8_WAIT_V(8); PG8_WAIT_L(0); PG8_BAR; PG8_MMA(0, 0, At, B0); PG8_MMA(0, 1, At, B1); PG8_BAR; PG8_SCHED;
            PG8_LDA(At, 0, 1); PG8_STAGE(PG8_SB(0, 0), b2, voffB); PG8_STAGE(PG8_SB(0, 1), b2 + hstepB, voffB); PG8_STAGE(PG8_SA(0, 0), a2, v20);
            PG8_WAIT_V(8); PG8_WAIT_L(0); PG8_BAR; PG8_MMA(1, 0, At, B0); PG8_MMA(1, 1, At, B1); PG8_BAR; PG8_SCHED;
            PG8_LDB(B0, 1, 0); PG8_LDB(B1, 1, 1); PG8_SCHED; PG8_LDA(At, 1, 0); PG8_STAGE(PG8_SA(0, 1), a2, v21);
            PG8_WAIT_V(8); PG8_WAIT_L(0); PG8_BAR; PG8_MMA(0, 0, At, B0); PG8_MMA(0, 1, At, B1); PG8_BAR; PG8_SCHED;
            PG8_LDA(At, 1, 1); PG8_STAGE(PG8_SB(1, 0), b3, voffB); PG8_STAGE(PG8_SB(1, 1), b3 + hstepB, voffB); PG8_STAGE(PG8_SA(1, 0), a3, v20);
            PG8_WAIT_V(8); PG8_WAIT_L(0); PG8_BAR; PG8_MMA(1, 0, At, B0); PG8_MMA(1, 1, At, B1); PG8_BAR; PG8_SCHED;
        }
        }
        if (wr == 0) PG8_BAR;
        E(acc, cur, wr, wc, fr, fq);
        if (!has_next) break;
#pragma unroll
        for (int a = 0; a < 2; ++a)
#pragma unroll
            for (int b = 0; b < 2; ++b)
#pragma unroll
                for (int m = 0; m < 4; ++m)
#pragma unroll
                    for (int n = 0; n < 2; ++n) acc[a][b][m][n] = (f32x4){0.f, 0.f, 0.f, 0.f};
        cur = nxt; cA = nA; cB = nB; ++ui;
        if constexpr (GATHER) {
#pragma unroll
            for (int h = 0; h < 2; ++h)
#pragma unroll
                for (int i = 0; i < 2; ++i) vaC[h][i] = vaN[h][i]; }
        if (wr == 1) PG8_BAR;
    }
    PG8_WAIT_V(0);
    PG8_BAR;
#undef PG8_SA
#undef PG8_SB
#undef PG8_STAGE
#undef PG8_LDA
#undef PG8_LDB
#undef PG8_MMA
#undef PG8_WAIT_V
#undef PG8_WAIT_L
#undef PG8_BAR
#undef PG8_SCHED
#undef PG8_KOFF
#undef PG8_GATHER
}

struct SchedG {
    TileOrder o; const char* A; const char* B; int astep, bstep; int nx;
    __device__ __forceinline__ bool next(int i, Unit& u) const {
        const long L = (long)i * o.G + o.c;
        if (L < o.nwg) { o.tile((int)L, u.pm, u.pn); }
        else { const int x = (int)(L - o.nwg); if (x >= nx) return false; u.pm = 128 + (x >> 2); u.pn = 2 + (x & 3); }
        u.aux = u.pm; u.A = A + (size_t)u.pm * astep; u.B = B + (size_t)u.pn * bstep; return true;
    }
};
struct SchedMoe {
    TileOrder o; int p0, nmain, ptail; const int* pexp; const char* A; int astep; const char* B; int estride, bstep;
    int own; long extraL;
    __device__ __forceinline__ bool next(int i, Unit& u) const {
        long L;
        if (i < own) L = (long)i * o.G + o.c; else if (i == own && extraL >= 0) L = extraL; else return false;
        if (L >= o.nwg) return false;
        o.tile((int)L, u.pm, u.pn);
        u.aux = u.pm < nmain ? p0 + u.pm : ptail + (u.pm - nmain);
        const int e = __builtin_amdgcn_readfirstlane(pexp[u.aux]);
        u.A = A + (size_t)u.pm * astep; u.B = B + (size_t)e * estride + (size_t)u.pn * bstep; return true;
    }
};
struct SchedOne {
    bool has; Unit u0;
    __device__ __forceinline__ bool next(int i, Unit& u) const { if (i != 0 || !has) return false; u = u0; return true; }
};

typedef f32x4 Acc[2][2][4][2];
__device__ __forceinline__ u32x4 pack8(const f32x4 v0, const f32x4 v1) { u32x4 w; w.x = cvt_pk_bf16(v0[0], v0[1]); w.y = cvt_pk_bf16(v0[2], v0[3]); w.z = cvt_pk_bf16(v1[0], v1[1]); w.w = cvt_pk_bf16(v1[2], v1[3]); return w; }

template <bool I8> struct EpiZ {
    static constexpr bool MIDK = false;
    static __device__ __forceinline__ f32x4 val(const f32x4& a, const float S) { if constexpr (I8) { const i32x4 q = __builtin_bit_cast(i32x4, a); return (f32x4){(float)q[0] * S, (float)q[1] * S, (float)q[2] * S, (float)q[3] * S}; } else return a; }
    unsigned char* ws;
    __device__ __forceinline__ void rescale(Acc&, const Unit&, int, int, int, int, int) const {}
    __device__ __forceinline__ void operator()(const Acc& acc, const Unit& u, int wr, int wc, int fr, int fq) const {
        const int pm = u.pm, pn = u.pn; const bool isctx = pm >= 128;
        bf16_t* const Q = (bf16_t*)(ws + WS_Q); bf16_t* const Kb = (bf16_t*)(ws + WS_K); bf16_t* const Vb = (bf16_t*)(ws + WS_V); bf16_t* const CB = (bf16_t*)(ws + WS_CB);
        bf16_t* const U = (bf16_t*)(ws + WS_U); bf16_t* const PIN = (bf16_t*)(ws + WS_PIN); bf16_t* const GT = (bf16_t*)(ws + WS_GT);
        const float* const ropeC = (const float*)(ws + WS_ROPE); const float* const ropeS = ropeC + 1024;
        int mode, pitch = 512, colt; bf16_t* base; bool krow = false;
        if (pn < 2) { mode = isctx ? 0 : 1; base = Q; colt = 256 * pn; }
        else if (pn < 4) { mode = isctx ? 0 : 1; base = Kb; colt = 256 * (pn - 2); krow = true; }
        else if (pn < 6) { mode = 0; base = Vb; colt = 256 * (pn - 4); krow = true; }
        else if (pn < 8) { mode = 0; base = CB; colt = 256 * (pn - 6); }
        else if (pn < 12) { mode = 2; base = U; colt = 128 * (pn - 8); }
        else if (pn < 14) { mode = 0; base = PIN; colt = 256 * (pn - 12); }
        else { mode = 3; base = GT; pitch = 1536; colt = 128 * (pn - 14); }
        const long rowbase = krow ? (isctx ? (long)(pm - 128) * TALL : (long)(pm >> 4) * TALL + CTXL + (pm & 15) * 256) : (long)pm * 256;
        const int cl = wc * 32 + 8 * fq;
#pragma unroll
        for (int ai = 0; ai < 2; ++ai)
#pragma unroll
            for (int m = 0; m < 4; ++m) {
                const int rl = ai * 128 + wr * 64 + m * 16 + fr;
                const float S = (I8 ? (1.0f / (24.0f * 1024.0f)) : 1.0f) * (pn < 2 ? 0.18033688011112042f : 1.0f);
                bf16_t* rowp = base + (size_t)(rowbase + rl) * pitch + colt + cl;
                if (mode == 2) {
                    const f32x4 a0 = val(acc[ai][0][m][0], S) * val(acc[ai][1][m][0], S), a1 = val(acc[ai][0][m][1], S) * val(acc[ai][1][m][1], S);
                    *(u32x4*)rowp = pack8(a0, a1);
                } else if (mode == 1) {
                    const int pos = (wc & 1) ? (m * 16 + fr) : ((pm & 15) * 4 + 2 * ai + wr);
                    const f32x4 cs = *(const f32x4*)(ropeC + pos * 16 + 4 * fq), sn = *(const f32x4*)(ropeS + pos * 16 + 4 * fq);
#pragma unroll
                    for (int bj = 0; bj < 2; ++bj) { const f32x4 v0 = val(acc[ai][bj][m][0], S), v1 = val(acc[ai][bj][m][1], S);
                        *(u32x4*)(rowp + bj * 128) = pack8(v0 * cs - v1 * sn, v1 * cs + v0 * sn); }
                } else if (mode == 3) {
#pragma unroll
                    for (int bj = 0; bj < 2; ++bj) { f32x4 v0 = val(acc[ai][bj][m][0], S), v1 = val(acc[ai][bj][m][1], S);
#pragma unroll
                        for (int j = 0; j < 4; ++j) { v0[j] = fmaxf(255.0f * fast_rcp(1.f + __builtin_amdgcn_exp2f(-1.4426950408889634f * v0[j])), 1.0f); v1[j] = fmaxf(255.0f * fast_rcp(1.f + __builtin_amdgcn_exp2f(-1.4426950408889634f * v1[j])), 1.0f); }
                        u32x2 w; w.x = __builtin_amdgcn_cvt_pk_u8_f32(v0[3], 3, __builtin_amdgcn_cvt_pk_u8_f32(v0[2], 2, __builtin_amdgcn_cvt_pk_u8_f32(v0[1], 1, __builtin_amdgcn_cvt_pk_u8_f32(v0[0], 0, 0u))));
                        w.y = __builtin_amdgcn_cvt_pk_u8_f32(v1[3], 3, __builtin_amdgcn_cvt_pk_u8_f32(v1[2], 2, __builtin_amdgcn_cvt_pk_u8_f32(v1[1], 1, __builtin_amdgcn_cvt_pk_u8_f32(v1[0], 0, 0u))));
                        *(u32x2*)((unsigned char*)(base + (size_t)(rowbase + rl) * pitch + colt) + cl + bj * 128) = w; }
                } else {
#pragma unroll
                    for (int bj = 0; bj < 2; ++bj) *(u32x4*)(rowp + bj * 128) = pack8(val(acc[ai][bj][m][0], S), val(acc[ai][bj][m][1], S));
                }
                asm volatile("" ::: "memory");
            }
    }
};
struct EpiPlain {
    static constexpr bool MIDK = false;
    bf16_t* O; int ldc; float scale;
    __device__ __forceinline__ void rescale(Acc&, const Unit&, int, int, int, int, int) const {}
    __device__ __forceinline__ void operator()(const Acc& acc, const Unit& u, int wr, int wc, int fr, int fq) const {
        const int cl = u.pn * 256 + wc * 32 + 8 * fq;
#pragma unroll
        for (int ai = 0; ai < 2; ++ai)
#pragma unroll
            for (int m = 0; m < 4; ++m) { bf16_t* rowp = O + (size_t)(u.pm * 256 + ai * 128 + wr * 64 + m * 16 + fr) * ldc + cl;
#pragma unroll
                for (int bj = 0; bj < 2; ++bj) *(u32x4*)(rowp + bj * 128) = pack8(acc[ai][bj][m][0] * scale, acc[ai][bj][m][1] * scale); }
    }
};
struct EpiGlu {
    static constexpr bool MIDK = false;
    bf16_t* O;
    __device__ __forceinline__ void rescale(Acc&, const Unit&, int, int, int, int, int) const {}
    __device__ __forceinline__ void operator()(const Acc& acc, const Unit& u, int wr, int wc, int fr, int fq) const {
        const int cl = u.pn * 128 + wc * 32 + 8 * fq;
#pragma unroll
        for (int ai = 0; ai < 2; ++ai)
#pragma unroll
            for (int m = 0; m < 4; ++m) { bf16_t* rowp = O + (size_t)(u.pm * 256 + ai * 128 + wr * 64 + m * 16 + fr) * DFF + cl;
                f32x4 g0 = acc[ai][0][m][0], g1 = acc[ai][0][m][1];
#pragma unroll
                for (int j = 0; j < 4; ++j) { g0[j] = silu_f(g0[j]); g1[j] = silu_f(g1[j]); }
                *(u32x4*)rowp = pack8(g0 * acc[ai][1][m][0], g1 * acc[ai][1][m][1]); }
    }
};
__device__ __forceinline__ unsigned pk_i8x4(float a, float b, float c, float d) {
    const int qa = (int)rintf(fminf(fmaxf(a, -127.f), 127.f)), qb = (int)rintf(fminf(fmaxf(b, -127.f), 127.f)), qc = (int)rintf(fminf(fmaxf(c, -127.f), 127.f)), qd = (int)rintf(fminf(fmaxf(d, -127.f), 127.f));
    return (unsigned)(qa & 255) | ((unsigned)(qb & 255) << 8) | ((unsigned)(qc & 255) << 16) | ((unsigned)qd << 24);
}
constexpr float I8_SW = 1024.0f;
struct EpiGluI8 {
    static constexpr bool MIDK = false;
    bf16_t* O; const float* rs;
    __device__ __forceinline__ void rescale(Acc&, const Unit&, int, int, int, int, int) const {}
    __device__ __forceinline__ void operator()(const Acc& acc, const Unit& u, int wr, int wc, int fr, int fq) const {
        const int cl = u.pn * 128 + wc * 32 + 8 * fq;
        float Sv[2][4];
#pragma unroll
        for (int ai = 0; ai < 2; ++ai)
#pragma unroll
            for (int m = 0; m < 4; ++m) Sv[ai][m] = ld_agent(rs + u.aux * 256 + ai * 128 + wr * 64 + m * 16 + fr);
        asm volatile("s_waitcnt vmcnt(0)" ::: "memory"); __builtin_amdgcn_sched_barrier(0);
#pragma unroll
        for (int ai = 0; ai < 2; ++ai)
#pragma unroll
            for (int m = 0; m < 4; ++m) { bf16_t* rowp = O + (size_t)(u.pm * 256 + ai * 128 + wr * 64 + m * 16 + fr) * DFF + cl;
                const float S = Sv[ai][m] * (1.0f / I8_SW);
                f32x4 g0, g1, u0, u1;
#pragma unroll
                for (int j = 0; j < 4; ++j) { g0[j] = silu_f((float)__builtin_bit_cast(i32x4, acc[ai][0][m][0])[j] * S); g1[j] = silu_f((float)__builtin_bit_cast(i32x4, acc[ai][0][m][1])[j] * S);
                    u0[j] = (float)__builtin_bit_cast(i32x4, acc[ai][1][m][0])[j] * S; u1[j] = (float)__builtin_bit_cast(i32x4, acc[ai][1][m][1])[j] * S; }
                *(u32x4*)rowp = pack8(g0 * u0, g1 * u1); }
    }
};
struct EpiMerge {
    static constexpr bool MIDK = true;
    bf16_t* O; const unsigned char* GT;
    static __device__ __forceinline__ f32x4 ub4(unsigned w) { return (f32x4){(float)(w & 255u), (float)((w >> 8) & 255u), (float)((w >> 16) & 255u), (float)(w >> 24)}; }
    __device__ __forceinline__ void rescale(Acc& acc, const Unit& u, int j, int wr, int wc, int fr, int fq) const {
        const int cl = u.pn * 256 + wc * 32 + 8 * fq;
#pragma unroll
        for (int ai = 0; ai < 2; ++ai) {
            u32x2 ga[4][2], gb[4][2];
#pragma unroll
            for (int m = 0; m < 4; ++m) { const unsigned char* gp = GT + (size_t)(u.pm * 256 + ai * 128 + wr * 64 + m * 16 + fr) * 3072 + j * 1024 + cl;
#pragma unroll
                for (int bj = 0; bj < 2; ++bj) { ga[m][bj] = *(const u32x2*)(gp + bj * 128); gb[m][bj] = *(const u32x2*)(gp + 1024 + bj * 128); } }
            asm volatile("s_waitcnt vmcnt(0)" ::: "memory"); __builtin_amdgcn_sched_barrier(0);
#pragma unroll
            for (int m = 0; m < 4; ++m)
#pragma unroll
                for (int bj = 0; bj < 2; ++bj) { const u32x2 a = ga[m][bj], b = gb[m][bj];
                    const f32x4 a0 = ub4(a.x), a1 = ub4(a.y), b0 = ub4(b.x), b1 = ub4(b.y);
                    f32x4 r0, r1;
#pragma unroll
                    for (int i = 0; i < 4; ++i) { r0[i] = a0[i] * fast_rcp(b0[i]); r1[i] = a1[i] * fast_rcp(b1[i]); }
                    acc[ai][bj][m][0] *= r0; acc[ai][bj][m][1] *= r1; }
            __builtin_amdgcn_sched_barrier(0);
        }
    }
    __device__ __forceinline__ void operator()(const Acc& acc, const Unit& u, int wr, int wc, int fr, int fq) const {
        const int cl = u.pn * 256 + wc * 32 + 8 * fq;
        u32x2 ga[2][4][2];
#pragma unroll
        for (int ai = 0; ai < 2; ++ai)
#pragma unroll
            for (int m = 0; m < 4; ++m) { const unsigned char* gp = GT + (size_t)(u.pm * 256 + ai * 128 + wr * 64 + m * 16 + fr) * 3072 + 2048 + cl;
#pragma unroll
                for (int bj = 0; bj < 2; ++bj) ga[ai][m][bj] = *(const u32x2*)(gp + bj * 128); }
        asm volatile("s_waitcnt vmcnt(0)" ::: "memory"); __builtin_amdgcn_sched_barrier(0);
#pragma unroll
        for (int ai = 0; ai < 2; ++ai)
#pragma unroll
            for (int m = 0; m < 4; ++m) { const size_t row = (size_t)(u.pm * 256 + ai * 128 + wr * 64 + m * 16 + fr);
                bf16_t* rowp = O + row * 1024 + cl;
#pragma unroll
                for (int bj = 0; bj < 2; ++bj) { const u32x2 a = ga[ai][m][bj];
                    const f32x4 g0 = ub4(a.x) * (1.0f / 255.0f), g1 = ub4(a.y) * (1.0f / 255.0f);
                    *(u32x4*)(rowp + bj * 128) = pack8(acc[ai][bj][m][0] * g0, acc[ai][bj][m][1] * g1); }
                }
    }
};
}

namespace att {
constexpr int KVBLK = 64;
constexpr float SCALE = 0.125f, THR = 8.f;
constexpr int LDQ = 512;
constexpr size_t SHM_V = KVBLK * 128 * 2, SHM_K = KVBLK * 128 * 2;
#define KSWZ(row, colB) ((row) * 256 + ((colB) ^ (((row) & 7) << 4)))
#define SBAR() __builtin_amdgcn_sched_barrier(0)
__device__ __forceinline__ int crow(int r, int hi) { return (r & 3) + 8 * (r >> 2) + 4 * hi; }
__device__ __forceinline__ void partialSM(f32x16& p0, f32x16& p1, float& m_reg, float& mn, float& alpha) {
    constexpr float THR2 = THR * 1.4426950408889634f;
    float mx0 = fmaxf(p0[0], p0[1]), mx1 = fmaxf(p0[2], p0[3]), mx2 = fmaxf(p1[0], p1[1]), mx3 = fmaxf(p1[2], p1[3]);
#pragma unroll
    for (int r = 4; r < 16; r += 2) { mx0 = fmaxf(mx0, p0[r]); mx1 = fmaxf(mx1, p0[r + 1]); mx2 = fmaxf(mx2, p1[r]); mx3 = fmaxf(mx3, p1[r + 1]); }
    float pmax = fmaxf(fmaxf(mx0, mx1), fmaxf(mx2, mx3));
    { auto rr = __builtin_amdgcn_permlane32_swap(__float_as_uint(pmax), __float_as_uint(pmax), false, false);
      pmax = fmaxf(__uint_as_float(rr[0]), __uint_as_float(rr[1])); }
    alpha = 1.f; mn = m_reg;
    if (__builtin_expect(!__all(pmax <= THR2), 0)) {
        const float d = fmaxf(pmax, 0.f);
        alpha = __builtin_amdgcn_exp2f(-d); m_reg += d; mn = m_reg;
#pragma unroll
        for (int r = 0; r < 16; ++r) { p0[r] -= d; p1[r] -= d; }
    }
#pragma unroll
    for (int r = 0; r < 16; ++r) p0[r] = __builtin_amdgcn_exp2f(p0[r]);
}
__device__ __forceinline__ void finishSM(f32x16& p0, f32x16& p1, float alpha, float& l_reg, bf16x8& pa0, bf16x8& pa1, bf16x8& pa2, bf16x8& pa3) {
#pragma unroll
    for (int r = 0; r < 16; ++r) p1[r] = __builtin_amdgcn_exp2f(p1[r]);
    float ps = 0;
#pragma unroll
    for (int r = 0; r < 16; ++r) ps += p0[r];
#pragma unroll
    for (int r = 0; r < 16; ++r) ps += p1[r];
    { auto rr = __builtin_amdgcn_permlane32_swap(__float_as_uint(ps), __float_as_uint(ps), false, false);
      ps = __uint_as_float(rr[0]) + __uint_as_float(rr[1]); }
    l_reg = l_reg * alpha + ps;
#define PK4(P, BASE, OUT) do { unsigned a0 = cvt_pk_bf16(P[BASE + 0], P[BASE + 1]), a1 = cvt_pk_bf16(P[BASE + 2], P[BASE + 3]);   \
    unsigned b0 = cvt_pk_bf16(P[BASE + 4], P[BASE + 5]), b1 = cvt_pk_bf16(P[BASE + 6], P[BASE + 7]);                              \
    auto r0 = __builtin_amdgcn_permlane32_swap(a0, b0, false, false); auto r1 = __builtin_amdgcn_permlane32_swap(a1, b1, false, false); \
    u32x4 w = {r0[0], r1[0], r0[1], r1[1]}; OUT = *reinterpret_cast<bf16x8*>(&w); } while (0)
    PK4(p0, 0, pa0); PK4(p0, 8, pa1); PK4(p1, 0, pa2); PK4(p1, 8, pa3);
#undef PK4
}
__device__ __forceinline__ void qkt(f32x16& p0, f32x16& p1, const char* Ks, const bf16x8* qr, int r32, int hi, int map) {
    p0 = f32x16{}; p1 = f32x16{};
#pragma unroll
    for (int d0 = 0; d0 < 4; ++d0) { const int cb = (map * 64 + d0 * 16 + hi * 8) * 2;
        const bf16x8 b0 = *reinterpret_cast<const bf16x8*>(Ks + KSWZ(r32, cb));
        const bf16x8 b1 = *reinterpret_cast<const bf16x8*>(Ks + KSWZ(32 + r32, cb));
        p0 = __builtin_amdgcn_mfma_f32_32x32x16_bf16(b0, qr[d0], p0, 0, 0, 0);
        p1 = __builtin_amdgcn_mfma_f32_32x32x16_bf16(b1, qr[d0], p1, 0, 0, 0); }
}
__device__ __forceinline__ void qktL(f32x16& p0, f32x16& p1, const LAS char* Ks, const bf16x8* qr, int r32, int hi, int map, const float negm) {
#pragma unroll
    for (int r = 0; r < 16; ++r) { p0[r] = negm; p1[r] = negm; }
#pragma unroll
    for (int d0 = 0; d0 < 4; ++d0) { const int cb = (map * 64 + d0 * 16 + hi * 8) * 2;
        const bf16x8 b0 = *reinterpret_cast<const LAS bf16x8*>(Ks + KSWZ(r32, cb));
        const bf16x8 b1 = *reinterpret_cast<const LAS bf16x8*>(Ks + KSWZ(32 + r32, cb));
        p0 = __builtin_amdgcn_mfma_f32_32x32x16_bf16(b0, qr[d0], p0, 0, 0, 0);
        p1 = __builtin_amdgcn_mfma_f32_32x32x16_bf16(b1, qr[d0], p1, 0, 0, 0); }
}
__device__ __forceinline__ int v_st(int k, int c) { const int kk = (k & ~0xC) | ((k & 4) << 1) | ((k & 8) >> 1); return ((kk >> 3) * 4 + (c >> 5)) * 512 + ((kk & 7) * 32 + (c & 31)) * 2; }
__device__ __forceinline__ int v_rd_base(int lane) { return ((lane & 3) << 3) | (((lane >> 2) & 3) << 6) | (((lane >> 4) & 1) << 5) | (((lane >> 5) & 1) << 8); }
constexpr int v_rd_off(int d0, int ks, int half) { return d0 * 512 + ks * 4096 + half * 2048; }
template <int OFF> __device__ __forceinline__ s16x4 tr_read(int vb) {
    s16x4 r; asm volatile("ds_read_b64_tr_b16 %0, %1 offset:%2" : "=&v"(r) : "v"(vb), "i"(OFF) : "memory"); return r;
}
struct VFrag { s16x4 l0, h0, l1, h1, l2, h2, l3, h3; };
template <int D0> __device__ __forceinline__ void v_issue(VFrag& f, int vb) {
    f.l0 = tr_read<v_rd_off(D0, 0, 0)>(vb); f.h0 = tr_read<v_rd_off(D0, 0, 1)>(vb); f.l1 = tr_read<v_rd_off(D0, 1, 0)>(vb); f.h1 = tr_read<v_rd_off(D0, 1, 1)>(vb);
    f.l2 = tr_read<v_rd_off(D0, 2, 0)>(vb); f.h2 = tr_read<v_rd_off(D0, 2, 1)>(vb); f.l3 = tr_read<v_rd_off(D0, 3, 0)>(vb); f.h3 = tr_read<v_rd_off(D0, 3, 1)>(vb);
}
__device__ __forceinline__ void v_mma(f32x16& od, const VFrag& f, bf16x8 pa0, bf16x8 pa1, bf16x8 pa2, bf16x8 pa3) {
#define PK(L, H) (bf16x8){L[0], L[1], L[2], L[3], H[0], H[1], H[2], H[3]}
    od = __builtin_amdgcn_mfma_f32_32x32x16_bf16(pa0, PK(f.l0, f.h0), od, 0, 0, 0);
    od = __builtin_amdgcn_mfma_f32_32x32x16_bf16(pa1, PK(f.l1, f.h1), od, 0, 0, 0);
    od = __builtin_amdgcn_mfma_f32_32x32x16_bf16(pa2, PK(f.l2, f.h2), od, 0, 0, 0);
    od = __builtin_amdgcn_mfma_f32_32x32x16_bf16(pa3, PK(f.l3, f.h3), od, 0, 0, 0);
#undef PK
}
__device__ __forceinline__ void pv_d0(f32x16* o, int vb, bf16x8 pa0, bf16x8 pa1, bf16x8 pa2, bf16x8 pa3) {
    VFrag fa, fb;
    v_issue<0>(fa, vb);
    v_issue<1>(fb, vb); asm volatile("s_waitcnt lgkmcnt(8)" ::: "memory"); SBAR(); v_mma(o[0], fa, pa0, pa1, pa2, pa3); SBAR();
    v_issue<2>(fa, vb); asm volatile("s_waitcnt lgkmcnt(8)" ::: "memory"); SBAR(); v_mma(o[1], fb, pa0, pa1, pa2, pa3); SBAR();
    v_issue<3>(fb, vb); asm volatile("s_waitcnt lgkmcnt(8)" ::: "memory"); SBAR(); v_mma(o[2], fa, pa0, pa1, pa2, pa3); SBAR();
    asm volatile("s_waitcnt lgkmcnt(0)" ::: "memory"); SBAR(); v_mma(o[3], fb, pa0, pa1, pa2, pa3);
}

__device__ __forceinline__ void attn_unit(const bf16_t* __restrict__ Qb, const bf16_t* __restrict__ Kh, const bf16_t* __restrict__ Vh, bf16_t* __restrict__ Ob,
                                          const int seq, const float lam, const float* __restrict__ gs, char* lds) {
    int tid = threadIdx.x; asm volatile("" : "+v"(tid));
    const int wid = __builtin_amdgcn_readfirstlane(tid >> 6), lane = tid & 63, r32 = lane & 31, hi = lane >> 5, map = wid >> 2, wq = wid & 3;
    LAS char* const L = (LAS char*)(uintptr_t)(unsigned)(uintptr_t)lds;
    constexpr int KRING = 0, VRING = 3 * 16384, SCR = 6 * 16384;
    float* ws = (float*)(lds + SCR) + wid * 64; float* li_l = ws; float* al_l = ws + 32;
    float m_reg = 0.f, l_reg = 0; f32x16 o[4] = {}; bf16x8 qr[4];
    const bf16_t* Qw = Qb + (long)(wq * 32 + r32) * LDQ + map * 64 + hi * 8;
#pragma unroll
    for (int d0 = 0; d0 < 4; ++d0) qr[d0] = *reinterpret_cast<const bf16x8*>(Qw + d0 * 16);
    unsigned kOff[2], vOff[2];
#pragma unroll
    for (int jj = 0; jj < 2; ++jj) { const int g = (wid * 2 + jj) * 64 + lane;
        { const int row = g >> 4, c = (g & 15) ^ (row & 7); kOff[jj] = (unsigned)(row * 512 + 8 * c); }
        { const int st = g >> 5, within = (g & 31) * 16, kk = (st >> 2) * 8 + (within >> 6), c = (st & 3) * 32 + ((within & 63) >> 1), k = (kk & ~0xC) | ((kk & 4) << 1) | ((kk & 8) >> 1); vOff[jj] = (unsigned)(k * 512 + c); } }
    const int vbase = (int)(uintptr_t)lds + VRING + v_rd_base(lane);
#define DMA_K(slot, key0) do { const bf16_t* kb_ = Kh + (size_t)(key0) * 512; asm volatile("" : "+s"(kb_)); _Pragma("unroll") for (int jj_ = 0; jj_ < 2; ++jj_) \
        __builtin_amdgcn_global_load_lds((const unsigned*)(kb_ + kOff[jj_]), (LAS unsigned*)(L + KRING + (slot) * 16384 + (wid * 2 + jj_) * 1024), 16, 0, 0); } while (0)
#define DMA_V(slot, key0) do { const bf16_t* vb_ = Vh + (size_t)(key0) * 512; asm volatile("" : "+s"(vb_)); _Pragma("unroll") for (int jj_ = 0; jj_ < 2; ++jj_) \
        __builtin_amdgcn_global_load_lds((const unsigned*)(vb_ + vOff[jj_]), (LAS unsigned*)(L + VRING + (slot) * 16384 + (wid * 2 + jj_) * 1024), 16, 0, 0); } while (0)
#define WAITBAR(n) do { asm volatile("s_waitcnt vmcnt(" #n ")" ::: "memory"); __builtin_amdgcn_s_barrier(); asm volatile("" ::: "memory"); } while (0)
#define RESC(a) do { if (__any((a) < 1.f)) { if (hi == 0) al_l[r32] = (a); asm volatile("s_waitcnt lgkmcnt(0)" ::: "memory"); \
    _Pragma("unroll") for (int d = 0; d < 4; ++d) _Pragma("unroll") for (int r = 0; r < 16; ++r) o[d][r] *= al_l[crow(r, hi)]; } } while (0)
    f32x16 pA0, pA1, pB0, pB1; float mnA, mnB, alA, alB; bf16x8 pa0, pa1, pa2, pa3; const int NT = seq / KVBLK;
    int ks = 0, vs = 0;
#define NEXT3(x) ((x) == 2 ? 0 : (x) + 1)
#define PREV3(x) ((x) == 0 ? 2 : (x) - 1)
    DMA_K(0, 0); DMA_K(1, KVBLK); DMA_V(0, 0);
    WAITBAR(4);
    DMA_K(2, 2 * KVBLK); DMA_V(1, KVBLK);
    qktL(pA0, pA1, L + KRING, qr, r32, hi, map, -m_reg); partialSM(pA0, pA1, m_reg, mnA, alA);
    ks = 1; vs = 0;
    for (int j = 1; j + 1 < NT; j += 2) {
        WAITBAR(4);
        if (j + 2 < NT) DMA_K(PREV3(ks), (j + 2) * KVBLK);
        DMA_V(PREV3(vs), (j + 1) * KVBLK);
        SBAR(); qktL(pB0, pB1, L + KRING + ks * 16384, qr, r32, hi, map, -m_reg);
        finishSM(pA0, pA1, alA, l_reg, pa0, pa1, pa2, pa3); SBAR();
        pv_d0(o, vbase + vs * 16384, pa0, pa1, pa2, pa3); partialSM(pB0, pB1, m_reg, mnB, alB);
        RESC(alB);
        ks = NEXT3(ks); vs = NEXT3(vs);
        if (j + 2 < NT) WAITBAR(4); else WAITBAR(2);
        if (j + 3 < NT) DMA_K(PREV3(ks), (j + 3) * KVBLK);
        if (j + 2 < NT) DMA_V(PREV3(vs), (j + 2) * KVBLK);
        SBAR(); qktL(pA0, pA1, L + KRING + ks * 16384, qr, r32, hi, map, -m_reg);
        finishSM(pB0, pB1, alB, l_reg, pa0, pa1, pa2, pa3); SBAR();
        pv_d0(o, vbase + vs * 16384, pa0, pa1, pa2, pa3); partialSM(pA0, pA1, m_reg, mnA, alA);
        RESC(alA);
        ks = NEXT3(ks); vs = NEXT3(vs);
    }
    WAITBAR(2);
    SBAR(); qktL(pB0, pB1, L + KRING + ks * 16384, qr, r32, hi, map, -m_reg);
    finishSM(pA0, pA1, alA, l_reg, pa0, pa1, pa2, pa3); SBAR();
    pv_d0(o, vbase + vs * 16384, pa0, pa1, pa2, pa3); partialSM(pB0, pB1, m_reg, mnB, alB);
    RESC(alB);
    vs = NEXT3(vs);
    WAITBAR(0);
    finishSM(pB0, pB1, alB, l_reg, pa0, pa1, pa2, pa3); SBAR();
    pv_d0(o, vbase + vs * 16384, pa0, pa1, pa2, pa3);
    if (hi == 0) li_l[r32] = l_reg; asm volatile("s_waitcnt lgkmcnt(0)" ::: "memory");
    float rli[16];
#pragma unroll
    for (int r = 0; r < 16; ++r) rli[r] = 1.0f / li_l[crow(r, hi)];
#pragma unroll
    for (int d0 = 0; d0 < 4; ++d0)
#pragma unroll
        for (int r = 0; r < 16; ++r) o[d0][r] *= rli[r];
    __syncthreads();
    float* X = (float*)lds + wq * (32 * 128);
    if (map == 1) {
#pragma unroll
        for (int d0 = 0; d0 < 4; ++d0)
#pragma unroll
            for (int r = 0; r < 16; ++r) X[crow(r, hi) * 128 + d0 * 32 + r32] = o[d0][r];
    }
    __syncthreads();
    if (map == 0) {
#pragma unroll
        for (int d0 = 0; d0 < 4; ++d0)
#pragma unroll
            for (int r = 0; r < 16; ++r) o[d0][r] -= lam * X[crow(r, hi) * 128 + d0 * 32 + r32];
        float g4[4];
#pragma unroll
        for (int d0 = 0; d0 < 4; ++d0) g4[d0] = gs[d0 * 32 + r32];
#pragma unroll
        for (int r = 0; r < 16; ++r) {
            float ss = o[0][r] * o[0][r] + o[1][r] * o[1][r] + o[2][r] * o[2][r] + o[3][r] * o[3][r];
            ss += __shfl_xor(ss, 1); ss += __shfl_xor(ss, 2); ss += __shfl_xor(ss, 4); ss += __shfl_xor(ss, 8); ss += __shfl_xor(ss, 16);
            const float rstd = 1.0f / sqrtf(ss * (1.0f / 128.0f) + EPS);
            bf16_t* op = Ob + (long)(wq * 32 + crow(r, hi)) * 512 + r32;
#pragma unroll
            for (int d0 = 0; d0 < 4; ++d0) op[d0 * 32] = (bf16_t)(cvt_pk_bf16(o[d0][r] * rstd * g4[d0], 0.f) & 0xffffu);
        }
    }
    __syncthreads();
#undef DMA_K
#undef DMA_V
#undef WAITBAR
#undef RESC
#undef NEXT3
#undef PREV3
}
#undef KSWZ
}

struct Args { const float* in[28]; float* out; unsigned char* ws; int ph_lo, ph_hi; };

struct Frame {
    LAS unsigned char* lds; volatile LAS unsigned* MISC;
    int c, G;
    float* out; unsigned char* ws;
};
template <int I> __device__ __forceinline__ const float* inp() {
    unsigned long long p;
    asm volatile("s_load_dwordx2 %0, %1, %2\n\ts_waitcnt lgkmcnt(0)" : "=s"(p) : "s"(__builtin_amdgcn_kernarg_segment_ptr()), "n"(I * 8));
    return (const float*)(const GAS float*)p;
}
enum { I_X = 0, I_C, I_CTX, I_CCTX, I_WMOD, I_BMOD, I_GPREMIX, I_GPOSTMIX, I_GPREFFN, I_GPOSTFFN, I_WIN, I_LQ1, I_LK1, I_LQ2, I_LK2, I_GSUB, I_CONVW, I_POOLW, I_POOLS,
       I_WBR, I_WOUT, I_FG, I_FU, I_FD, I_RW, I_MG, I_MU, I_MD };

__device__ __forceinline__ int rowmap_f(int kind, int off, int n) {
    if (kind == 0) return n + off;
    if (kind == 2) return ((n >> 7) << 8) + off + (n & 127);
    if (n < 1024) { const int ch = n >> 6, o = n & 63, a = o >> 5, hh = (o >> 4) & 1, f = o & 15; return ch * 64 + a * 32 + 8 * (f >> 2) + 4 * hh + (f & 3); }
    if (n >= 2048 && n < 3072) { const int x = n - 2048, isx = x >> 9, chn = x & 511; return 2048 + ((chn >> 7) << 8) + isx * 128 + (chn & 127); }
    return n;
}
__device__ __forceinline__ void tr_item(const float* __restrict__ W, int N, int k0, int n0, bf16_t* __restrict__ WT, int ldt, int kc0, int kind, int off, LAS float* scr, int lane) {
    float tv[32];
#pragma unroll
    for (int i = 0; i < 32; ++i) tv[i] = W[(size_t)(k0 + 2 * i + (lane >> 5)) * N + n0 + (lane & 31)];
#pragma unroll
    for (int i = 0; i < 32; ++i) scr[(2 * i + (lane >> 5)) * 33 + (lane & 31)] = tv[i];
    LDS_WAIT(); asm volatile("" ::: "memory");
    const int c = lane & 7;
#pragma unroll
    for (int j = 0; j < 4; ++j) { const int n = (lane >> 3) + 8 * j; const LAS float* s = scr + (8 * c) * 33 + n;
        u32x4 o; o.x = cvt_pk_bf16(s[0 * 33], s[1 * 33]); o.y = cvt_pk_bf16(s[2 * 33], s[3 * 33]); o.z = cvt_pk_bf16(s[4 * 33], s[5 * 33]); o.w = cvt_pk_bf16(s[6 * 33], s[7 * 33]);
        *(u32x4*)(WT + (size_t)rowmap_f(kind, off, n0 + n) * ldt + kc0 + k0 + 8 * c) = o; }
    LDS_WAIT(); asm volatile("" ::: "memory");
}
__device__ __forceinline__ void tr_item8(const float* __restrict__ W, int N, int k0, int n0, unsigned char* __restrict__ WT, int ldt, int kind, int off, LAS float* scr, int lane) {
    float tv[32];
#pragma unroll
    for (int i = 0; i < 32; ++i) tv[i] = W[(size_t)(k0 + 2 * i + (lane >> 5)) * N + n0 + (lane & 31)];
#pragma unroll
    for (int i = 0; i < 32; ++i) scr[(2 * i + (lane >> 5)) * 33 + (lane & 31)] = tv[i];
    LDS_WAIT(); asm volatile("" ::: "memory");
    const int c = lane & 3;
#pragma unroll
    for (int j = 0; j < 2; ++j) { const int n = (lane >> 2) + 16 * j; const LAS float* sp = scr + (16 * c) * 33 + n;
        u32x4 o;
        constexpr float SW = pg8::I8_SW;
        o.x = pg8::pk_i8x4(sp[0 * 33] * SW, sp[1 * 33] * SW, sp[2 * 33] * SW, sp[3 * 33] * SW); o.y = pg8::pk_i8x4(sp[4 * 33] * SW, sp[5 * 33] * SW, sp[6 * 33] * SW, sp[7 * 33] * SW);
        o.z = pg8::pk_i8x4(sp[8 * 33] * SW, sp[9 * 33] * SW, sp[10 * 33] * SW, sp[11 * 33] * SW); o.w = pg8::pk_i8x4(sp[12 * 33] * SW, sp[13 * 33] * SW, sp[14 * 33] * SW, sp[15 * 33] * SW);
        *(u32x4*)(WT + (size_t)rowmap_f(kind, off, n0 + n) * ldt + k0 + 16 * c) = o; }
    LDS_WAIT(); asm volatile("" ::: "memory");
}
__device__ __forceinline__ void tr_job(int r, const float* W, int K, int N, bf16_t* WT, int ldt, int kc0, int kind, int off, LAS float* scr, int lane) {
    const int nblk = N / 32, kb = r / nblk, nb = r % nblk;
    tr_item(W, N, 64 * kb, 32 * nb, WT, ldt, kc0, kind, off, scr, lane);
}

__device__ __forceinline__ void p_conv(Frame& F) {
    int tid = threadIdx.x; asm volatile("" : "+v"(tid)); const int lane = tid & 63, wave = __builtin_amdgcn_readfirstlane(tid >> 6); (void)lane; (void)wave;

    unsigned char* ws = F.ws;
    LAS float* scr = (LAS float*)(F.lds + wave * 16384);
    const int gw = F.c * NWAVES + wave, NGW = F.G * NWAVES;
    constexpr int I_IN = 8 * 208, I_BR = 8 * 32, I_O = 16 * 32, I_GU = 8 * 88, I_D = 44 * 32;
    constexpr int NIT = 2 * I_IN + 4 * I_BR + 2 * I_O + 2 * I_GU + I_D;
    for (int it = gw; it < NIT; it += NGW) {
        int r = it;
        if (r < 2 * I_IN) { const int l = r / I_IN; r -= l * I_IN; const int nblk = INW / 32, nb = r % nblk, j = r / nblk;
            tr_item8(inp<I_WIN>() + (size_t)l * DM * INW, INW, 128 * j, 32 * nb, ws + (l ? WS_WIN1 : WS_WIN0), DM, 1, 0, scr, lane);
            tr_item8(inp<I_WIN>() + (size_t)l * DM * INW, INW, 128 * j + 64, 32 * nb, ws + (l ? WS_WIN1 : WS_WIN0), DM, 1, 0, scr, lane); continue; } r -= 2 * I_IN;
        if (r < 4 * I_BR) { const int l = r / (2 * I_BR), j = (r / I_BR) & 1; r %= I_BR; tr_job(r, inp<I_WBR>() + (size_t)(l * 3 + j) * 512 * DM, 512, DM, (bf16_t*)(ws + (l ? WS_WM1 : WS_WM0)), 1536, 512 * j, 0, 0, scr, lane); continue; } r -= 4 * I_BR;
        if (r < 2 * I_O) { const int l = r / I_O; r -= l * I_O; tr_job(r, inp<I_WOUT>() + (size_t)l * DM * DM, DM, DM, (bf16_t*)(ws + (l ? WS_WO1 : WS_WO0)), DM, 0, 0, 0, scr, lane); continue; } r -= 2 * I_O;
        if (r < 2 * I_GU) { const int up = r / I_GU; r -= up * I_GU; const int nblk = DFF / 32, nb = r % nblk, j = r / nblk; const float* W = up ? inp<I_FU>() : inp<I_FG>();
            tr_item8(W, DFF, 128 * j, 32 * nb, ws + WS_WGU, DM, 2, up * 128, scr, lane);
            tr_item8(W, DFF, 128 * j + 64, 32 * nb, ws + WS_WGU, DM, 2, up * 128, scr, lane); continue; } r -= 2 * I_GU;
        tr_job(r, inp<I_FD>(), DFF, DM, (bf16_t*)(ws + WS_WD), DFF, 0, 0, 0, scr, lane);
    }
    __syncthreads();
    {
        LAS float* pwT = (LAS float*)F.lds;
        for (int item = F.c; item < 2 * 8 * 16; item += F.G) {
            const int nb = item & 15, blk = (item >> 4) & 7, l = item >> 7, g = blk >> 1;
            const float* pw = inp<I_POOLW>() + ((size_t)l * 512 + blk * 64) * 128;
#pragma unroll
            for (int i = 0; i < 16; ++i) { const int idx = tid + 512 * i; pwT[(idx & 127) * 65 + (idx >> 7)] = pw[idx]; }
            __syncthreads();
            const float* ps = inp<I_POOLS>() + l * 512 + g * 128;
            const int n0 = nb * 64 + wave * 8;
            const float* wb = inp<I_WBR>() + ((size_t)(l * 3 + 2) * 512 + g * 128) * DM + n0;
            float fa[8];
#pragma unroll
            for (int j = 0; j < 8; ++j) fa[j] = 0.f;
#pragma unroll 4
            for (int c = 0; c < 128; ++c) { const float p = pwT[c * 65 + lane] * ps[c]; const f32x4 w0 = *(const f32x4*)(wb + (size_t)c * DM), w1 = *(const f32x4*)(wb + (size_t)c * DM + 4);
                fa[0] += p * w0[0]; fa[1] += p * w0[1]; fa[2] += p * w0[2]; fa[3] += p * w0[3]; fa[4] += p * w1[0]; fa[5] += p * w1[1]; fa[6] += p * w1[2]; fa[7] += p * w1[3]; }
            bf16_t* dst = (bf16_t*)(ws + (l ? WS_WM1 : WS_WM0)) + (size_t)n0 * 1536 + 1024 + blk * 64 + lane;
#pragma unroll
            for (int j = 0; j < 8; ++j) dst[(size_t)j * 1536] = (bf16_t)(cvt_pk_bf16(fa[j], 0.f) & 0xffffu);
            __syncthreads();
        }
    }
    __syncthreads();
    {
        LAS float* sl = (LAS float*)F.lds;
        LAS float* part = (LAS float*)(F.lds + 40960);
        for (int i = tid; i < 9 * 1024; i += NTHREADS) { const float v = (i < 8192) ? inp<I_C>()[i] : inp<I_CCTX>()[i - 8192]; sl[i] = silu_f(v); }
        __syncthreads();
        for (int item = F.c; item < 192; item += F.G) {
            const int l = item / 96, j0 = (item % 96) * 64;
            const float* wm = inp<I_WMOD>() + (size_t)l * DM * 6144 + j0 + lane;
            float a[9];
#pragma unroll
            for (int r = 0; r < 9; ++r) a[r] = 0.f;
            const int kb = wave * 128;
#pragma unroll 8
            for (int k = 0; k < 128; ++k) { const float w = wm[(size_t)(kb + k) * 6144];
#pragma unroll
                for (int r = 0; r < 9; ++r) a[r] += sl[r * 1024 + kb + k] * w; }
#pragma unroll
            for (int r = 0; r < 9; ++r) part[(wave * 9 + r) * 64 + lane] = a[r];
            __syncthreads();
            for (int i = tid; i < 576; i += NTHREADS) { const int r = i >> 6, ln = i & 63; float s = inp<I_BMOD>()[l * 6144 + j0 + ln];
#pragma unroll
                for (int w = 0; w < 8; ++w) s += part[(w * 9 + r) * 64 + ln];
                ((float*)(ws + WS_MOD))[(size_t)(l * 9 + r) * 6144 + j0 + ln] = s; }
            __syncthreads();
        }
    }
    if (F.c == 0) {
        float* rc = (float*)(ws + WS_ROPE); float* rs = rc + 1024;
        for (int i = tid; i < 1024; i += NTHREADS) { const int pos = i >> 4, f = i & 15; const float inv = powf(10000.0f, -(float)f / 16.0f); const float ang = (float)pos * inv; rc[i] = cosf(ang); rs[i] = sinf(ang); }
        if (wave == 0) {
            for (int l = 0; l < 2; ++l) {
                const float a = wave_sum(inp<I_LQ1>()[l * 64 + lane] * inp<I_LK1>()[l * 64 + lane]);
                const float b = wave_sum(inp<I_LQ2>()[l * 64 + lane] * inp<I_LK2>()[l * 64 + lane]);
                const float lam_init = l ? 0.35550907f : 0.2f;
                if (lane == 0) ((float*)(ws + WS_LAM))[l] = expf(a) - expf(b) + lam_init;
            }
        }
    }
}
__device__ __forceinline__ void p_conv_moe(Frame& F, const int wg0) {
    int tid = threadIdx.x; asm volatile("" : "+v"(tid)); const int lane = tid & 63, wave = __builtin_amdgcn_readfirstlane(tid >> 6); (void)lane; (void)wave;
    if (F.c < wg0) return;
    LAS float* scr = (LAS float*)(F.lds + wave * 16384);
    const int gw = (F.c - wg0) * NWAVES + wave, NGW = (F.G - wg0) * NWAVES;
    constexpr int I_GU = 8 * 88, I_D = 44 * 32, PER_E = 2 * I_GU + I_D;
    for (int it = gw; it < NE * PER_E; it += NGW) {
        const int e = it / PER_E; int r = it % PER_E;
        unsigned char* we = (unsigned char*)F.out + (size_t)e * MOE_ESTRIDE;
        if (r < 2 * I_GU) { const int up = r / I_GU; r -= up * I_GU; const int nblk = DFF / 32, nb = r % nblk, j = r / nblk; const float* W = (up ? inp<I_MU>() : inp<I_MG>()) + (size_t)e * DM * DFF;
            tr_item8(W, DFF, 128 * j, 32 * nb, we, DM, 2, up * 128, scr, lane);
            tr_item8(W, DFF, 128 * j + 64, 32 * nb, we, DM, 2, up * 128, scr, lane); }
        else { r -= 2 * I_GU; tr_job(r, inp<I_MD>() + (size_t)e * DFF * DM, DFF, DM, (bf16_t*)(we + MOE_WD_OFF), DFF, 0, 0, 0, scr, lane); }
    }
}

__device__ __forceinline__ void ld_row_f32(const float* p, int lane, f32x4 (&v)[4]) {
#pragma unroll
    for (int j = 0; j < 4; ++j) v[j] = *(const f32x4*)(p + 4 * lane + 256 * j);
}
__device__ __forceinline__ void ld_row_bf16(const bf16_t* p, int lane, f32x4 (&v)[4]) {
#pragma unroll
    for (int j = 0; j < 4; ++j) { const u32x2 w = *(const u32x2*)(p + 4 * lane + 256 * j); v[j] = (f32x4){bf_lo(w.x), bf_hi(w.x), bf_lo(w.y), bf_hi(w.y)}; }
}
__device__ __forceinline__ void st_row_bf16(bf16_t* p, int lane, const f32x4 (&v)[4]) {
#pragma unroll
    for (int j = 0; j < 4; ++j) { u32x2 w; w.x = cvt_pk_bf16(v[j][0], v[j][1]); w.y = cvt_pk_bf16(v[j][2], v[j][3]); *(u32x2*)(p + 4 * lane + 256 * j) = w; }
}
__device__ __forceinline__ void st_row_f32(float* p, int lane, const f32x4 (&v)[4]) {
#pragma unroll
    for (int j = 0; j < 4; ++j) *(f32x4*)(p + 4 * lane + 256 * j) = v[j];
}
__device__ __forceinline__ float row_ss(const f32x4 (&v)[4]) {
    float s = 0.f;
#pragma unroll
    for (int j = 0; j < 4; ++j) s += (v[j][0] * v[j][0] + v[j][1] * v[j][1]) + (v[j][2] * v[j][2] + v[j][3] * v[j][3]);
    return wave_sum(s);
}
__device__ __forceinline__ void norm_mod_store(const f32x4 (&x)[4], const float* g, const float* sh, const float* sc, bf16_t* dst, int lane, f32x4 (&h)[4]) {
    const float rstd = 1.0f / sqrtf(row_ss(x) * (1.0f / DM) + EPS);
    f32x4 gv[4], sv[4], cv[4]; ld_row_f32(g, lane, gv); ld_row_f32(sh, lane, sv); ld_row_f32(sc, lane, cv);
#pragma unroll
    for (int j = 0; j < 4; ++j) h[j] = (x[j] * rstd * gv[j]) * (1.0f + cv[j]) + sv[j];
    st_row_bf16(dst, lane, h);
}
__device__ __forceinline__ void ld_row_raw(const bf16_t* p, int lane, u32x2 (&w)[4]) {
#pragma unroll
    for (int j = 0; j < 4; ++j) w[j] = *(const u32x2*)(p + 4 * lane + 256 * j);
}
__device__ __forceinline__ void cvt_row(const u32x2 (&w)[4], f32x4 (&v)[4]) {
#pragma unroll
    for (int j = 0; j < 4; ++j) v[j] = (f32x4){bf_lo(w[j].x), bf_hi(w[j].x), bf_lo(w[j].y), bf_hi(w[j].y)};
}
__device__ __forceinline__ void norm_mod_store_v(const f32x4 (&x)[4], const f32x4 (&gv)[4], const f32x4 (&sv)[4], const f32x4 (&cv)[4], bf16_t* dst, int lane, f32x4 (&h)[4]) {
    const float rstd = 1.0f / sqrtf(row_ss(x) * (1.0f / DM) + EPS);
#pragma unroll
    for (int j = 0; j < 4; ++j) h[j] = (x[j] * rstd * gv[j]) * (1.0f + cv[j]) + sv[j];
    st_row_bf16(dst, lane, h);
}
__device__ __forceinline__ void norm_mod_store8(const f32x4 (&x)[4], const f32x4 (&gv)[4], const f32x4 (&sv)[4], const f32x4 (&cv)[4], unsigned char* dst, float* rs, int lane, f32x4 (&h)[4]) {
    const float rstd = 1.0f / sqrtf(row_ss(x) * (1.0f / DM) + EPS);
    float am = 0.f;
#pragma unroll
    for (int j = 0; j < 4; ++j) { h[j] = (x[j] * rstd * gv[j]) * (1.0f + cv[j]) + sv[j]; am = fmaxf(am, fmaxf(fmaxf(fabsf(h[j][0]), fabsf(h[j][1])), fmaxf(fabsf(h[j][2]), fabsf(h[j][3])))); }
#pragma unroll
    for (int o = 1; o < 64; o <<= 1) am = fmaxf(am, __shfl_xor(am, o));
    am = fmaxf(am, 1e-20f);
    const float inv = 127.0f / am;
#pragma unroll
    for (int j = 0; j < 4; ++j) *(unsigned*)(dst + 4 * lane + 256 * j) = pg8::pk_i8x4(h[j][0] * inv, h[j][1] * inv, h[j][2] * inv, h[j][3] * inv);
    if (lane == 0) st_agent(rs, am * (1.0f / 127.0f));
}
__device__ __forceinline__ void norm_mod_store8f(const f32x4 (&x)[4], const f32x4 (&gv)[4], const f32x4 (&sv)[4], const f32x4 (&cv)[4], unsigned char* dst, float* rs, int lane, f32x4 (&h)[4]) {
    const float rstd = 1.0f / sqrtf(row_ss(x) * (1.0f / DM) + EPS);
#pragma unroll
    for (int j = 0; j < 4; ++j) { h[j] = (x[j] * rstd * gv[j]) * (1.0f + cv[j]) + sv[j]; *(unsigned*)(dst + 4 * lane + 256 * j) = pg8::pk_i8x4(h[j][0] * 24.f, h[j][1] * 24.f, h[j][2] * 24.f, h[j][3] * 24.f); }
}
__device__ __forceinline__ void pair_range(int gw, int NGW, int npairs, int& pb, int& pe) { pb = (int)(((long)gw * npairs) / NGW); pe = (int)(((long)(gw + 1) * npairs) / NGW); }
__device__ __forceinline__ void p_h0(Frame& F) {
    int tid = threadIdx.x; asm volatile("" : "+v"(tid)); const int lane = tid & 63, wave = __builtin_amdgcn_readfirstlane(tid >> 6);
    int pb, pe; pair_range(F.c * NWAVES + wave, F.G * NWAVES, MT / 2, pb, pe);
    f32x4 gv[4], sv[4], cv[4]; int mrc = -1;
    for (int p = pb; p < pe; ++p) {
        const int row = 2 * p; const bool lat = row < ML; const int mr = lat ? (row >> 12) : 8;
        const float* xin = lat ? inp<I_X>() + (size_t)row * DM : inp<I_CTX>() + (size_t)(row - ML) * DM;
        f32x4 xa[4], xb[4], h[4];
        ld_row_f32(xin, lane, xa); ld_row_f32(xin + DM, lane, xb);
        if (mr != mrc) { const float* mod = (const float*)(F.ws + WS_MOD) + (size_t)mr * 6144; ld_row_f32(inp<I_GPREMIX>(), lane, gv); ld_row_f32(mod, lane, sv); ld_row_f32(mod + 1024, lane, cv); mrc = mr; }
        norm_mod_store8f(xa, gv, sv, cv, F.ws + WS_H + (size_t)row * DM, (float*)(F.ws + WS_RSH) + row, lane, h);
        norm_mod_store8f(xb, gv, sv, cv, F.ws + WS_H + (size_t)(row + 1) * DM, (float*)(F.ws + WS_RSH) + row + 1, lane, h);
    }
}
__device__ __forceinline__ void route_row(Frame& F, const f32x4 (&h)[4], LAS float* rwt, volatile LAS int* cntl, int row, int lane) {
    float lg[8];
#pragma unroll
    for (int e = 0; e < 8; ++e) { float s = 0.f;
#pragma unroll
        for (int j = 0; j < 4; ++j) { const f32x4 w = *(const LAS f32x4*)(rwt + e * 1024 + 4 * lane + 256 * j); s += (h[j][0] * w[0] + h[j][1] * w[1]) + (h[j][2] * w[2] + h[j][3] * w[3]); }
        lg[e] = wave_sum(s); }
    int e0 = 0; float v0 = lg[0];
#pragma unroll
    for (int e = 1; e < 8; ++e) if (lg[e] > v0) { v0 = lg[e]; e0 = e; }
    int e1 = -1; float v1 = -3.0e38f;
#pragma unroll
    for (int e = 0; e < 8; ++e) if (e != e0 && lg[e] > v1) { v1 = lg[e]; e1 = e; }
    const float ex = expf(v1 - v0), p0 = 1.0f / (1.0f + ex), p1 = ex * p0;
    if (lane == 0) { ((int*)(F.ws + WS_TKE))[row * 2] = e0; ((int*)(F.ws + WS_TKE))[row * 2 + 1] = e1;
        ((float*)(F.ws + WS_TKP))[row * 2] = p0; ((float*)(F.ws + WS_TKP))[row * 2 + 1] = p1;
        __hip_atomic_fetch_add((LAS int*)&cntl[e0], 1, __ATOMIC_RELAXED, __HIP_MEMORY_SCOPE_WORKGROUP); __hip_atomic_fetch_add((LAS int*)&cntl[e1], 1, __ATOMIC_RELAXED, __HIP_MEMORY_SCOPE_WORKGROUP); }
}
__device__ __forceinline__ void nr1_pair(Frame& F, const int l, const int row, const int lane, LAS float* rwt, volatile LAS int* cntl,
                                         const f32x4 (&g)[4], const f32x4 (&gv)[4], const f32x4 (&sv)[4], const f32x4 (&cv)[4]) {
    const bf16_t* MIX = (const bf16_t*)(F.ws + WS_MIX);
    const bool lat = row < ML;
    const float* xin = lat ? inp<I_X>() + (size_t)row * DM : inp<I_CTX>() + (size_t)(row - ML) * DM;
    bf16_t* x16 = (bf16_t*)(F.ws + WS_X16) + (size_t)row * DM;
    float* yo = (float*)(F.ws + WS_Y) + (size_t)(row - ML) * DM;
    u32x2 wa[4], wb[4]; f32x4 xa[4], xb[4], mx[4], h[4];
    ld_row_raw(MIX + (size_t)row * DM, lane, wa); ld_row_raw(MIX + (size_t)(row + 1) * DM, lane, wb);
    if (l == 0) { ld_row_f32(xin, lane, xa); ld_row_f32(xin + DM, lane, xb); }
    else { u32x2 ra[4], rb[4]; ld_row_raw(x16, lane, ra); ld_row_raw(x16 + DM, lane, rb); cvt_row(ra, xa); cvt_row(rb, xb); }
    cvt_row(wa, mx);
    { const float rstd = 1.0f / sqrtf(row_ss(mx) * (1.0f / DM) + EPS);
#pragma unroll
      for (int j = 0; j < 4; ++j) xa[j] = xa[j] + g[j] * (mx[j] * rstd); }
    if (lat) st_row_bf16(x16, lane, xa); else st_row_f32(yo, lane, xa);
    norm_mod_store8(xa, gv, sv, cv, F.ws + (l ? WS_H : WS_H2_0) + (size_t)row * DM, (float*)(F.ws + (l ? WS_RSH : WS_RSH2)) + row, lane, h);
    if (l == 1) route_row(F, h, rwt, cntl, row, lane);
    cvt_row(wb, mx);
    { const float rstd = 1.0f / sqrtf(row_ss(mx) * (1.0f / DM) + EPS);
#pragma unroll
      for (int j = 0; j < 4; ++j) xb[j] = xb[j] + g[j] * (mx[j] * rstd); }
    if (lat) st_row_bf16(x16 + DM, lane, xb); else st_row_f32(yo + DM, lane, xb);
    norm_mod_store8(xb, gv, sv, cv, F.ws + (l ? WS_H : WS_H2_0) + (size_t)(row + 1) * DM, (float*)(F.ws + (l ? WS_RSH : WS_RSH2)) + row + 1, lane, h);
    if (l == 1) route_row(F, h, rwt, cntl, row + 1, lane);
}
__device__ __forceinline__ void nr1_vectors(Frame& F, const int l, const int mr, const int lane, f32x4 (&g)[4], f32x4 (&gv)[4], f32x4 (&sv)[4], f32x4 (&cv)[4]) {
    const float* mod = (const float*)(F.ws + WS_MOD) + (size_t)(l * 9 + mr) * 6144; f32x4 gt[4];
    ld_row_f32(inp<I_GPOSTMIX>() + l * DM, lane, g); ld_row_f32(mod + 2048, lane, gt);
    ld_row_f32(inp<I_GPREFFN>() + l * DM, lane, gv); ld_row_f32(mod + 3072, lane, sv); ld_row_f32(mod + 4096, lane, cv);
#pragma unroll
    for (int j = 0; j < 4; ++j) g[j] = g[j] * gt[j];
}
__device__ __forceinline__ void p_nr1(Frame& F, const int l) {
    int tid = threadIdx.x; asm volatile("" : "+v"(tid)); const int lane = tid & 63, wave = __builtin_amdgcn_readfirstlane(tid >> 6);
    LAS float* rwt = (LAS float*)F.lds;
    volatile LAS int* cntl = (volatile LAS int*)(F.MISC + 16);
    f32x4 g[4], gv[4], sv[4], cv[4];
    if (l == 1) {
        for (int i = tid; i < 8192; i += NTHREADS) rwt[(i & 7) * 1024 + (i >> 3)] = inp<I_RW>()[i];
        for (int ch = F.c; ch < ML / 128; ch += F.G) {
            if (tid < 8) cntl[tid] = 0;
            __syncthreads();
            nr1_vectors(F, 1, (ch * 128) >> 12, lane, g, gv, sv, cv);
            for (int i = 0; i < 16; i += 2) nr1_pair(F, 1, ch * 128 + wave * 16 + i, lane, rwt, cntl, g, gv, sv, cv);
            __syncthreads();
            if (tid < 8) st_agent((int*)(F.ws + WS_CNT) + ch * 8 + tid, cntl[tid]);
            __syncthreads();
        }
    } else {
        int pb, pe; pair_range(F.c * NWAVES + wave, F.G * NWAVES, MT / 2, pb, pe); int mrc = -1;
        for (int p = pb; p < pe; ++p) { const int row = 2 * p, mr = row < ML ? (row >> 12) : 8;
            if (mr != mrc) { nr1_vectors(F, 0, mr, lane, g, gv, sv, cv); mrc = mr; }
            nr1_pair(F, 0, row, lane, rwt, cntl, g, gv, sv, cv); }
    }
}
__device__ __forceinline__ void p_nr2(Frame& F, const int l) {
    int tid = threadIdx.x; asm volatile("" : "+v"(tid)); const int lane = tid & 63, wave = __builtin_amdgcn_readfirstlane(tid >> 6);
    const int nrows = l ? ML : MT;
    int pb, pe; pair_range(F.c * NWAVES + wave, F.G * NWAVES, nrows / 2, pb, pe); int mrc = -1;
    f32x4 g[4], gv[4], sv[4], cv[4];
    for (int p = pb; p < pe; ++p) {
        const int row = 2 * p; const bool lat = row < ML; const int mr = lat ? (row >> 12) : 8;
        bf16_t* x16 = (bf16_t*)(F.ws + WS_X16) + (size_t)row * DM; float* yp = (float*)(F.ws + WS_Y) + (size_t)(row - ML) * DM;
        f32x4 fa[4], fb[4], xa[4], xb[4], h[4];
        if (lat) { u32x2 ra[4], rb[4]; ld_row_raw(x16, lane, ra); ld_row_raw(x16 + DM, lane, rb); cvt_row(ra, xa); cvt_row(rb, xb); } else { ld_row_f32(yp, lane, xa); ld_row_f32(yp + DM, lane, xb); }
        if (l == 0) { u32x2 wa[4], wb[4];
            ld_row_raw((const bf16_t*)(F.ws + WS_F_0) + (size_t)row * DM, lane, wa); ld_row_raw((const bf16_t*)(F.ws + WS_F_0) + (size_t)(row + 1) * DM, lane, wb);
            cvt_row(wa, fa); cvt_row(wb, fb);
        } else {
            const int* ps = (const int*)(F.ws + WS_PSLOT) + row * 2; const float* pp = (const float*)(F.ws + WS_TKP) + row * 2;
            const int s0 = ps[0], s1 = ps[1], s2 = ps[2], s3 = ps[3]; const float p0 = pp[0], p1 = pp[1], p2 = pp[2], p3 = pp[3];
            u32x2 w0[4], w1[4], w2[4], w3[4]; const bf16_t* OP = (const bf16_t*)(F.ws + WS_OUTP);
            ld_row_raw(OP + (size_t)s0 * DM, lane, w0); ld_row_raw(OP + (size_t)s1 * DM, lane, w1); ld_row_raw(OP + (size_t)s2 * DM, lane, w2); ld_row_raw(OP + (size_t)s3 * DM, lane, w3);
            f32x4 a[4], b[4]; cvt_row(w0, a); cvt_row(w1, b);
#pragma unroll
            for (int j = 0; j < 4; ++j) fa[j] = p0 * a[j] + p1 * b[j];
            cvt_row(w2, a); cvt_row(w3, b);
#pragma unroll
            for (int j = 0; j < 4; ++j) fb[j] = p2 * a[j] + p3 * b[j];
        }
        if (mr != mrc) { const float* mod = (const float*)(F.ws + WS_MOD) + (size_t)(l * 9 + mr) * 6144; f32x4 gt[4];
            ld_row_f32(inp<I_GPOSTFFN>() + l * DM, lane, g); ld_row_f32(mod + 5120, lane, gt);
#pragma unroll
            for (int j = 0; j < 4; ++j) g[j] = g[j] * gt[j];
            if (l == 0) { const float* mod1 = (const float*)(F.ws + WS_MOD) + (size_t)(9 + mr) * 6144; ld_row_f32(inp<I_GPREMIX>() + DM, lane, gv); ld_row_f32(mod1, lane, sv); ld_row_f32(mod1 + 1024, lane, cv); }
            mrc = mr; }
        { const float rstd = 1.0f / sqrtf(row_ss(fa) * (1.0f / DM) + EPS);
#pragma unroll
          for (int j = 0; j < 4; ++j) xa[j] = xa[j] + g[j] * (fa[j] * rstd); }
        if (!lat) st_row_f32(yp, lane, xa); else if (l == 0) st_row_bf16(x16, lane, xa); else st_row_f32(F.out + (size_t)row * DM, lane, xa);
        if (l == 0) norm_mod_store8f(xa, gv, sv, cv, F.ws + WS_H + (size_t)row * DM, (float*)(F.ws + WS_RSH) + row, lane, h);
        { const float rstd = 1.0f / sqrtf(row_ss(fb) * (1.0f / DM) + EPS);
#pragma unroll
          for (int j = 0; j < 4; ++j) xb[j] = xb[j] + g[j] * (fb[j] * rstd); }
        if (!lat) st_row_f32(yp + DM, lane, xb); else if (l == 0) st_row_bf16(x16 + DM, lane, xb); else st_row_f32(F.out + (size_t)(row + 1) * DM, lane, xb);
        if (l == 0) norm_mod_store8f(xb, gv, sv, cv, F.ws + WS_H + (size_t)(row + 1) * DM, (float*)(F.ws + WS_RSH) + row + 1, lane, h);
    }
}
__device__ __forceinline__ void p_convpool(Frame& F, const int l) {
    int tid = threadIdx.x; asm volatile("" : "+v"(tid)); const int lane = tid & 63, wave = __builtin_amdgcn_readfirstlane(tid >> 6); (void)lane; (void)wave;

    const int gw = F.c * NWAVES + wave, NGW = F.G * NWAVES;
    const bf16_t* CB = (const bf16_t*)(F.ws + WS_CB); const bf16_t* U = (const bf16_t*)(F.ws + WS_U); const bf16_t* PIN = (const bf16_t*)(F.ws + WS_PIN); bf16_t* P = (bf16_t*)(F.ws + WS_P);
    bf16_t* CO = l ? (bf16_t*)(F.ws + WS_CONVO1) : (bf16_t*)F.out;
    const int nrows = l ? ML : MT; const int c0 = 8 * lane;
    const float* cw = inp<I_CONVW>() + l * 1536 + c0;
    const f32x4 w0a = *(const f32x4*)(cw), w0b = *(const f32x4*)(cw + 4), w1a = *(const f32x4*)(cw + 512), w1b = *(const f32x4*)(cw + 516), w2a = *(const f32x4*)(cw + 1024), w2b = *(const f32x4*)(cw + 1028);
    const int g = lane >> 4, hw = 1 << g;
    for (int row = gw; row < nrows; row += NGW) {
        const bool lat = row < ML; const int t = lat ? (row & 4095) : ((row - ML) & 255), L = lat ? SEQ : CTXL;
        const u32x4 z4 = {0u, 0u, 0u, 0u};
        const u32x4 uc = *(const u32x4*)(U + (size_t)row * 512 + c0);
        const u32x4 up = t > 0 ? *(const u32x4*)(U + (size_t)(row - 1) * 512 + c0) : z4;
        const u32x4 un = t < L - 1 ? *(const u32x4*)(U + (size_t)(row + 1) * 512 + c0) : z4;
        const u32x4 cb = *(const u32x4*)(CB + (size_t)row * 512 + c0);
        const int lo = (t - hw) > 0 ? (t - hw) : 0, hi = (t + hw) < L ? (t + hw) : L;
        const bf16_t* pb = PIN + (size_t)(row - t) * 512 + c0;
        u32x4 wv[16];
#pragma unroll
        for (int j = 0; j < 16; ++j) { const int tt = t - hw + j; const bool ok = (j < 2 * hw) && tt >= 0 && tt < L; wv[j] = ok ? *(const u32x4*)(pb + (size_t)tt * 512) : z4; }
        const u32x4 w = *(const u32x4*)(pb + (size_t)t * 512);
        f32x4 o0, o1;
#define CV(w, lo_) ((lo_) ? bf_lo(w) : bf_hi(w))
        o0[0] = bf_lo(cb.x) * (w0a[0] * bf_lo(up.x) + w1a[0] * bf_lo(uc.x) + w2a[0] * bf_lo(un.x)); o0[1] = bf_hi(cb.x) * (w0a[1] * bf_hi(up.x) + w1a[1] * bf_hi(uc.x) + w2a[1] * bf_hi(un.x));
        o0[2] = bf_lo(cb.y) * (w0a[2] * bf_lo(up.y) + w1a[2] * bf_lo(uc.y) + w2a[2] * bf_lo(un.y)); o0[3] = bf_hi(cb.y) * (w0a[3] * bf_hi(up.y) + w1a[3] * bf_hi(uc.y) + w2a[3] * bf_hi(un.y));
        o1[0] = bf_lo(cb.z) * (w0b[0] * bf_lo(up.z) + w1b[0] * bf_lo(uc.z) + w2b[0] * bf_lo(un.z)); o1[1] = bf_hi(cb.z) * (w0b[1] * bf_hi(up.z) + w1b[1] * bf_hi(uc.z) + w2b[1] * bf_hi(un.z));
        o1[2] = bf_lo(cb.w) * (w0b[2] * bf_lo(up.w) + w1b[2] * bf_lo(uc.w) + w2b[2] * bf_lo(un.w)); o1[3] = bf_hi(cb.w) * (w0b[3] * bf_hi(up.w) + w1b[3] * bf_hi(uc.w) + w2b[3] * bf_hi(un.w));
#undef CV
        *(u32x4*)(CO + (size_t)row * 512 + c0) = pg8::pack8(o0, o1);
        f32x4 s0 = {0.f, 0.f, 0.f, 0.f}, s1 = {0.f, 0.f, 0.f, 0.f};
#pragma unroll
        for (int j = 0; j < 16; ++j) { s0 += (f32x4){bf_lo(wv[j].x), bf_hi(wv[j].x), bf_lo(wv[j].y), bf_hi(wv[j].y)}; s1 += (f32x4){bf_lo(wv[j].z), bf_hi(wv[j].z), bf_lo(wv[j].w), bf_hi(wv[j].w)}; }
        const float inv = 1.0f / (float)(hi - lo);
        s0 = s0 * inv - (f32x4){bf_lo(w.x), bf_hi(w.x), bf_lo(w.y), bf_hi(w.y)}; s1 = s1 * inv - (f32x4){bf_lo(w.z), bf_hi(w.z), bf_lo(w.w), bf_hi(w.w)};
        *(u32x4*)(P + (size_t)row * 512 + c0) = pg8::pack8(s0, s1);
    }
}
__device__ __forceinline__ void p_attn(Frame& F, const int l, char* lds) {
    int tid = threadIdx.x; asm volatile("" : "+v"(tid)); const int lane = tid & 63, wave = __builtin_amdgcn_readfirstlane(tid >> 6); (void)lane; (void)wave;

    const bf16_t* Q = (const bf16_t*)(F.ws + WS_Q); const bf16_t* Kb = (const bf16_t*)(F.ws + WS_K); const bf16_t* Vb = (const bf16_t*)(F.ws + WS_V); bf16_t* AO = (bf16_t*)(F.ws + WS_AO);
    const float lam = ((const float*)(F.ws + WS_LAM))[l];
    const float lam_init = l ? 0.35550907f : 0.2f;
    LAS float* gsl = (LAS float*)(F.lds + 100352);
    if (tid < 128) gsl[tid] = inp<I_GSUB>()[l * 128 + tid] * (1.0f - lam_init);
    __syncthreads();
    const float* gs = (const float*)(lds + 100352);
    for (int uid = F.c; uid < 1024; uid += F.G) {
        const int xcd = uid & 7, j = uid >> 3, qb = j & 31, bh = (j >> 5) * 8 + xcd, b = bh >> 2, h = bh & 3;
        const size_t qrow = (size_t)b * SEQ + qb * 128, krow = (size_t)b * TALL;
        att::attn_unit(Q + qrow * 512 + h * 128, Kb + krow * 512 + h * 128, Vb + krow * 512 + h * 128, AO + qrow * 512 + h * 128, TALL, lam, gs, lds);
    }
    if (l == 0) {
        for (int uid = F.c; uid < 64; uid += F.G) {
            const int b = uid >> 3, h = (uid >> 1) & 3, qb = uid & 1;
            const size_t qrow = (size_t)ML + b * CTXL + qb * 128, krow = (size_t)b * TALL;
            att::attn_unit(Q + qrow * 512 + h * 128, Kb + krow * 512 + h * 128, Vb + krow * 512 + h * 128, AO + qrow * 512 + h * 128, CTXL, lam, gs, lds);
        }
    }
}
__device__ __forceinline__ void p_route(Frame& F) {
    int tid = threadIdx.x; asm volatile("" : "+v"(tid)); const int lane = tid & 63, wave = __builtin_amdgcn_readfirstlane(tid >> 6); (void)lane; (void)wave;

    volatile LAS int* sm = (volatile LAS int*)F.lds;
    const int* CNT = (const int*)(F.ws + WS_CNT); const int* TKE = (const int*)(F.ws + WS_TKE);
    int* ROWMAP = (int*)(F.ws + WS_ROWMAP); int* PSLOT = (int*)(F.ws + WS_PSLOT); int* PEXP = (int*)(F.ws + WS_PEXP);
    for (int ch = F.c; ch < 256; ch += F.G) {
        if (tid < 64) sm[tid] = 0;
        __syncthreads();
        { const int e = tid & 7, part = tid >> 3; int lt = 0, lp = 0;
#pragma unroll
          for (int q = 0; q < 4; ++q) { const int cq = part * 4 + q; const int v = ld_agent(CNT + cq * 8 + e); lt += v; if (cq < ch) lp += v; }
          __hip_atomic_fetch_add((LAS int*)&sm[e], lt, __ATOMIC_RELAXED, __HIP_MEMORY_SCOPE_WORKGROUP); __hip_atomic_fetch_add((LAS int*)&sm[8 + e], lp, __ATOMIC_RELAXED, __HIP_MEMORY_SCOPE_WORKGROUP); }
        __syncthreads();
        if (tid == 0) { int b = 0; for (int e = 0; e < 8; ++e) { sm[16 + e] = b; b += (sm[e] + 255) & ~255; } sm[24] = b; }
        __syncthreads();
        int e = 0, rk = 0, tok = 0, k = 0;
        if (tid < 256) {
            const int tl = tid >> 1; k = tid & 1; tok = ch * 128 + tl; e = TKE[tok * 2 + k];
            const unsigned long long lt_mask = (1ull << lane) - 1ull;
#pragma unroll
            for (int ee = 0; ee < 8; ++ee) { const unsigned long long m = __ballot(e == ee); if (e == ee) rk = __popcll(m & lt_mask); if (lane == 0) sm[32 + wave * 8 + ee] = __popcll(m); }
        }
        __syncthreads();
        if (tid < 256) {
            int r = sm[16 + e] + sm[8 + e] + rk;
            for (int w = 0; w < wave; ++w) r += sm[32 + w * 8 + e];
            st_agent(ROWMAP + r, tok); PSLOT[tok * 2 + k] = r; st_agent((float*)(F.ws + WS_RSS) + r, ld_agent((const float*)(F.ws + WS_RSH) + tok));
        }
        if (ch < 8) { const int st = sm[16 + ch] + sm[ch], en = sm[16 + ch + 1]; for (int s = st + tid; s < en; s += NTHREADS) { st_agent(ROWMAP + s, 0); st_agent((float*)(F.ws + WS_RSS) + s, 0.f); } }
        if (ch == 8) { for (int p = tid; p < 272; p += NTHREADS) { int ee = 0;
#pragma unroll
                for (int q = 1; q < 8; ++q) if (p * 256 >= sm[16 + q]) ee = q;
                PEXP[p] = ee; }
            if (tid == 0) PEXP[272] = sm[24] >> 8; }
        __syncthreads();
    }
}

constexpr int NPH = 21;
__global__ void __launch_bounds__(NTHREADS, 2) mk_fwd(Args args) {
    extern __shared__ __attribute__((aligned(16))) unsigned char lds[];
    Frame F;
    F.lds = (LAS unsigned char*)lds; F.MISC = (volatile LAS unsigned*)(F.lds + MISC_OFF);
    const int tid0 = threadIdx.x;
    F.G = gridDim.x; F.c = blockIdx.x;
    F.out = args.out; F.ws = args.ws;
    unsigned char* ws = args.ws;
    for (int u = tid0; u < (LDS_BYTES - RING_BYTES) / 4; u += NTHREADS) ((LAS unsigned*)(F.lds + RING_BYTES))[u] = 0u;
    __syncthreads();
    const int lo = args.ph_lo, hi = args.ph_hi;
    XcdBarrier bar; bar.bar = (unsigned*)(ws + WS_CTL) + CW_BAR; bar.x = 0; bar.st = nullptr;
    if (hi - lo > 1) bar = xcd_barrier_post((unsigned*)(ws + WS_CTL) + CW_BAR, F.MISC + 8);
    int ph = 0;
#ifndef MK_SITES
#define MK_SITES 0xffffu
#endif
#ifndef MK_REPEAT
#define MK_REPEAT (-1)
#endif
#define PH_BEGIN(site) if (((MK_SITES >> (site)) & 1u) && ph >= lo && ph < hi) { for (int rep_ = 0; rep_ < ((site) == MK_REPEAT ? 2 : 1); ++rep_) { if (rep_) __syncthreads();
#define PH_END   } if (ph + 1 < hi) xcd_barrier(bar); } ++ph;

    PH_BEGIN(0) p_conv(F); PH_END
    PH_BEGIN(1) p_h0(F); PH_END

    for (int l = 0; l < 2; ++l) {
        PH_BEGIN(2)
            pg8::SchedG S; S.o.init(l ? 128 : 136, 26, F.G, F.c); S.A = (const char*)(ws + WS_H); S.B = (const char*)(ws + (l ? WS_WIN1 : WS_WIN0));
            S.astep = 256 * DM; S.bstep = 256 * DM; S.nx = l ? 32 : 0;
            pg8::EpiZ<true> E{ws};
            pg8::gemm_phase<pg8::EpiZ<true>, pg8::SchedG, false, false, true>(F.lds, DM / 2, DM / 2, DM / 2, S, E, 0, 0, nullptr);
        PH_END
        PH_BEGIN(3)
            if (rep_ == 0) p_convpool(F, l);
            p_attn(F, l, (char*)lds);
        PH_END
        PH_BEGIN(4)
            pg8::SchedG S; S.o.init(l ? 128 : 136, 4, F.G, F.c); S.A = (const char*)(ws + WS_AO); S.B = (const char*)(ws + (l ? WS_WM1 : WS_WM0));
            S.astep = 256 * 512 * 2; S.bstep = 256 * 1536 * 2; S.nx = 0;
            pg8::EpiMerge E{(bf16_t*)(ws + WS_MERGED), (const unsigned char*)(ws + WS_GT)};
            const long seg1 = l ? (long)WS_CONVO1 - (long)WS_AO : (long)((const char*)F.out - (const char*)(ws + WS_AO));
            pg8::gemm_phase<pg8::EpiMerge, pg8::SchedG, true, false>(F.lds, 1536, 512, 1536, S, E, seg1, (long)WS_P - (long)WS_AO, nullptr);
        PH_END
        PH_BEGIN(5)
            pg8::SchedG S; S.o.init(l ? 128 : 136, 4, F.G, F.c); S.A = (const char*)(ws + WS_MERGED); S.B = (const char*)(ws + (l ? WS_WO1 : WS_WO0));
            S.astep = 256 * DM * 2; S.bstep = 256 * DM * 2; S.nx = 0;
            pg8::EpiPlain E{(bf16_t*)(ws + WS_MIX), DM, 1.0f};
            pg8::gemm_phase<pg8::EpiPlain, pg8::SchedG, false, false>(F.lds, DM, DM, DM, S, E, 0, 0, nullptr);
        PH_END
        PH_BEGIN(6) p_nr1(F, l); PH_END
        if (l == 0) {
            PH_BEGIN(7)
                pg8::SchedG S; S.o.init(136, 22, F.G, F.c); S.A = (const char*)(ws + WS_H2_0); S.B = (const char*)(ws + WS_WGU);
                S.astep = 256 * DM; S.bstep = 256 * DM; S.nx = 0;
                pg8::EpiGluI8 E{(bf16_t*)(ws + WS_ACT0), (const float*)(ws + WS_RSH2)};
                pg8::gemm_phase<pg8::EpiGluI8, pg8::SchedG, false, false, true>(F.lds, DM / 2, DM / 2, DM / 2, S, E, 0, 0, nullptr);
            PH_END
            PH_BEGIN(8)
                pg8::SchedG S; S.o.init(136, 4, F.G, F.c); S.A = (const char*)(ws + WS_ACT0); S.B = (const char*)(ws + WS_WD);
                S.astep = 256 * DFF * 2; S.bstep = 256 * DFF * 2; S.nx = 0;
                pg8::EpiPlain E{(bf16_t*)(ws + WS_F_0), DM, 1.0f};
                pg8::gemm_phase<pg8::EpiPlain, pg8::SchedG, false, false>(F.lds, DFF, DFF, DFF, S, E, 0, 0, nullptr);
                __syncthreads(); p_conv_moe(F, 32);
            PH_END
        } else {
            PH_BEGIN(9) p_route(F); PH_END
            const int np_all = __builtin_amdgcn_readfirstlane(((const int*)(ws + WS_PEXP))[272]);
            int ntail = np_all - 256; ntail = ntail < 0 ? 0 : (ntail > 8 ? 8 : ntail);
            for (int ci = 0; ci < 2; ++ci) {
                int npc = np_all - 128 * ci; npc = npc < 0 ? 0 : (npc > 128 ? 128 : npc);
                const bool tailwg = ci == 1 && F.c < 32 && (F.c & 7) < ntail;
                PH_BEGIN(10)
                    if (tailwg) {
                        const int pt = F.c & 7, pn = F.c >> 3, e = __builtin_amdgcn_readfirstlane(((const int*)(ws + WS_PEXP))[256 + pt]);
                        pg8::SchedOne S; S.has = true; S.u0.pm = 256 + pt; S.u0.pn = pn; S.u0.aux = 256 + pt;
                        S.u0.A = (const char*)(ws + WS_ACT1) + (size_t)(128 + pt) * (256 * DFF * 2); S.u0.B = (const char*)F.out + MOE_WD_OFF + (size_t)e * MOE_ESTRIDE + (size_t)pn * (256 * DFF * 2);
                        pg8::EpiPlain E{(bf16_t*)(ws + WS_OUTP), DM, 1.0f};
                        pg8::gemm_phase<pg8::EpiPlain, pg8::SchedOne, false, false>(F.lds, DFF, DFF, DFF, S, E, 0, 0, nullptr);
                        __syncthreads();
                    }
                    const int nM = npc + (ci == 0 ? ntail : 0);
                    if (nM > 0) {
                        pg8::SchedMoe S; S.o.init(nM, 22, F.G, F.c); S.p0 = 128 * ci; S.nmain = npc; S.ptail = 256; S.pexp = (const int*)(ws + WS_PEXP); S.A = (const char*)(ws + WS_H); S.astep = 0;
                        S.B = (const char*)F.out; S.estride = (int)MOE_ESTRIDE; S.bstep = 256 * DM;
                        S.own = 0x7fffffff; S.extraL = -1;
                        if (ci == 1 && ntail > 0 && F.G == 256 && nM == 128) {
                            const int ntw = 4 * ntail;
                            if (tailwg) S.own = 7;
                            else { S.own = 11; const int k = F.c - 32; if (k >= 0 && k < 4 * ntw) { const int t = k % ntw; S.extraL = (long)(7 + k / ntw) * 256 + ((t % ntail) + 8 * (t / ntail)); } }
                        }
                        pg8::EpiGluI8 E{(bf16_t*)(ws + WS_ACT1), (const float*)(ws + WS_RSS)};
                        pg8::gemm_phase<pg8::EpiGluI8, pg8::SchedMoe, false, true, true>(F.lds, DM / 2, DM / 2, DM / 2, S, E, 0, 0, (const int*)(ws + WS_ROWMAP));
                    }
                PH_END
                PH_BEGIN(11)
                    if (npc > 0) {
                        pg8::SchedMoe S; S.o.init(npc, 4, F.G, F.c); S.p0 = 128 * ci; S.nmain = npc; S.ptail = 256; S.pexp = (const int*)(ws + WS_PEXP); S.A = (const char*)(ws + WS_ACT1); S.astep = 256 * DFF * 2;
                        S.B = (const char*)F.out + MOE_WD_OFF; S.estride = (int)MOE_ESTRIDE; S.bstep = 256 * DFF * 2;
                        S.own = 0x7fffffff; S.extraL = -1;
                        pg8::EpiPlain E{(bf16_t*)(ws + WS_OUTP) + (size_t)ci * 32768 * DM, DM, 1.0f};
                        pg8::gemm_phase<pg8::EpiPlain, pg8::SchedMoe, false, false>(F.lds, DFF, DFF, DFF, S, E, 0, 0, nullptr);
                    }
                PH_END
            }
        }
        PH_BEGIN(12) p_nr2(F, l); PH_END
    }
#undef PH_BEGIN
#undef PH_END
}

extern "C" void kernel_launch(void* const* d_in, const int* in_sizes, int n_in, void* d_out, int out_size, void* d_ws, size_t ws_size, hipStream_t stream) {
    static int grid = 0;
    if (grid == 0) {
        if (n_in != 28 || in_sizes[0] != ML * DM || out_size != ML * DM || ws_size < WS_END) {
            fprintf(stderr, "kernel_launch: shape/workspace mismatch (n_in %d, ws %zu, need %zu); nothing launched\n", n_in, ws_size, (size_t)WS_END); grid = -1; return; }
        if (hipFuncSetAttribute((const void*)mk_fwd, hipFuncAttributeMaxDynamicSharedMemorySize, LDS_BYTES) != hipSuccess) { fprintf(stderr, "kernel_launch: hipFuncSetAttribute failed\n"); grid = -1; return; }
        int dev = 0, cus = 0, per_cu = 0;
        if (hipGetDevice(&dev) != hipSuccess || hipDeviceGetAttribute(&cus, hipDeviceAttributeMultiprocessorCount, dev) != hipSuccess) { grid = -1; return; }
        if (hipOccupancyMaxActiveBlocksPerMultiprocessor(&per_cu, (const void*)mk_fwd, NTHREADS, LDS_BYTES) != hipSuccess || per_cu < 1)
            fprintf(stderr, "kernel_launch: occupancy query reports %d\n", per_cu);
        (void)hipGetLastError();
        grid = cus;
        if (grid != 256) fprintf(stderr, "kernel_launch: %d CUs (built for 256)\n", grid);
    }
    if (grid < 0) return;
    if (hipMemsetAsync((char*)d_ws + WS_CTL, 0, CTL_ZERO_BYTES, stream) != hipSuccess) return;
    Args a{};
    for (int i = 0; i < 28; ++i) a.in[i] = (const float*)d_in[i];
    a.out = (float*)d_out; a.ws = (unsigned char*)d_ws;
#if MK_MULTI
    for (int p = 0; p < NPH; ++p) { a.ph_lo = p; a.ph_hi = p + 1; hipLaunchKernelGGL(mk_fwd, dim3(grid), dim3(NTHREADS), LDS_BYTES, stream, a); }
#else
    a.ph_lo = 0; a.ph_hi = NPH;
    hipLaunchKernelGGL(mk_fwd, dim3(grid), dim3(NTHREADS), LDS_BYTES, stream, a);
#endif
    const hipError_t le = hipPeekAtLastError();
    if (le != hipSuccess) fprintf(stderr, "kernel_launch: launch failed: %s\n", hipGetErrorName(le));
}
```
